# Optimizing an MI355X kernel written in HIP

```python
import math
import jax, jax.numpy as jnp
from jax import lax
import numpy as np

D_MODEL = 1024
BATCH = 2
SEQ = 8192
DEPTH = 2
DEC_BATCH = 4
DEC_SEQ = 4096
PAST_LEN = 128

HEAD_DIM = 64
A_Q_HEADS = 8
A_KV_HEADS = 2
A_GROUP = A_Q_HEADS // A_KV_HEADS
B_HEADS = 4
B_V_DIM = 2 * HEAD_DIM
A_Q_W = A_Q_HEADS * HEAD_DIM
A_KV_W = A_KV_HEADS * HEAD_DIM
B_QK_W = B_HEADS * 2 * HEAD_DIM
B_V_W = B_HEADS * B_V_DIM
MIX_WIDTH = A_Q_W + B_V_W
IN_WIDTH = A_Q_W + 2 * A_KV_W + 2 * B_QK_W + B_V_W
MEM_LEN = 256
C_HEADS = 4
C_HEAD_DIM = 128
C_WIDTH = C_HEADS * C_HEAD_DIM
D_FF = -(-8 * D_MODEL // (3 * 256)) * 256
GRID_W = 64
Q_BLOCK = 128
ROPE_THETA = 10000.0
EPS = 1e-6

kernel_name = "hybrid_gqa_axialrope_diffattn_alibi_encoder"


def rms_norm(x, g):
    xf = x.astype(jnp.float32)
    y = xf * lax.rsqrt(jnp.mean(xf * xf, axis=-1, keepdims=True) + EPS)
    return (y * g.astype(jnp.float32)).astype(x.dtype)


def rms_norm_f32(x, g):
    xf = x.astype(jnp.float32)
    return xf * lax.rsqrt(jnp.mean(xf * xf, axis=-1, keepdims=True) + EPS) * g.astype(jnp.float32)


def axial_rope_tables(seq_len):
    rows = seq_len // GRID_W
    t_row = jnp.repeat(jnp.arange(rows), GRID_W).astype(jnp.float32)
    t_col = jnp.tile(jnp.arange(GRID_W), rows).astype(jnp.float32)
    n_freq = HEAD_DIM // 4
    inv = 1.0 / (ROPE_THETA ** (jnp.arange(n_freq, dtype=jnp.float32) / n_freq))
    ang_r = t_row[:, None] * inv[None, :]
    ang_c = t_col[:, None] * inv[None, :]
    return jnp.cos(ang_r), jnp.sin(ang_r), jnp.cos(ang_c), jnp.sin(ang_c)


def rope_half(x, cos, sin):
    x1, x2 = jnp.split(x, 2, axis=-1)
    return jnp.concatenate([x1 * cos - x2 * sin, x2 * cos + x1 * sin], axis=-1)


def apply_axial_rope(x, tables):
    cr, sr, cc, sc = tables
    xr, xc = jnp.split(x, 2, axis=-1)
    return jnp.concatenate([rope_half(xr, cr, sr), rope_half(xc, cc, sc)], axis=-1)


def gqa_axial(qa, ka, va, gq, gk, tables):
    bsz, seq, _ = qa.shape
    nb = seq // Q_BLOCK
    q = rms_norm_f32(qa.reshape(bsz, seq, A_Q_HEADS, HEAD_DIM), gq).transpose(0, 2, 1, 3)
    q = apply_axial_rope(q, tables)
    k = rms_norm_f32(ka.reshape(bsz, seq, A_KV_HEADS, HEAD_DIM), gk).transpose(0, 2, 1, 3)
    k = apply_axial_rope(k, tables)
    v = va.reshape(bsz, seq, A_KV_HEADS, HEAD_DIM).transpose(0, 2, 1, 3).astype(jnp.float32)
    q = q.reshape(bsz, A_KV_HEADS, A_GROUP, nb, Q_BLOCK, HEAD_DIM)
    q = jnp.moveaxis(q, 3, 0)
    scale = HEAD_DIM ** -0.5

    def block(qb):
        s = jnp.einsum('bhgqd,bhkd->bhgqk', qb, k) * scale
        p = jax.nn.softmax(s, axis=-1)
        return jnp.einsum('bhgqk,bhkd->bhgqd', p, v)

    o = lax.map(block, q)
    return o.transpose(1, 0, 4, 2, 3, 5).reshape(bsz, seq, A_Q_W)


def diff_alibi(qb_in, kb_in, vb_in, gq, gk, lq1, lk1, lq2, lk2, gsub, lam_init):
    bsz, seq, _ = qb_in.shape
    nb = seq // Q_BLOCK
    q = rms_norm_f32(qb_in.reshape(bsz, seq, B_HEADS, 2, HEAD_DIM), gq).transpose(0, 2, 3, 1, 4)
    k = rms_norm_f32(kb_in.reshape(bsz, seq, B_HEADS, 2, HEAD_DIM), gk).transpose(0, 2, 3, 1, 4)
    v = vb_in.reshape(bsz, seq, B_HEADS, B_V_DIM).transpose(0, 2, 1, 3).astype(jnp.float32)
    lam = (jnp.exp(jnp.sum(lq1.astype(jnp.float32) * lk1.astype(jnp.float32)))
           - jnp.exp(jnp.sum(lq2.astype(jnp.float32) * lk2.astype(jnp.float32))) + lam_init)
    slopes = 2.0 ** (-8.0 * jnp.arange(1, B_HEADS + 1, dtype=jnp.float32) / B_HEADS)
    kpos = jnp.arange(seq, dtype=jnp.float32)
    qblocks = jnp.moveaxis(q.reshape(bsz, B_HEADS, 2, nb, Q_BLOCK, HEAD_DIM), 3, 0)
    idx = jnp.arange(nb)
    scale = HEAD_DIM ** -0.5

    def block(args):
        qb, bi = args
        qpos = (bi * Q_BLOCK + jnp.arange(Q_BLOCK)).astype(jnp.float32)
        dist = jnp.abs(qpos[:, None] - kpos[None, :])
        s = jnp.einsum('bhcqd,bhckd->bhcqk', qb, k) * scale
        s = s - slopes[None, :, None, None, None] * dist[None, None, None]
        p = jax.nn.softmax(s, axis=-1)
        a = p[:, :, 0] - lam * p[:, :, 1]
        return jnp.einsum('bhqk,bhkv->bhqv', a, v)

    o = lax.map(block, (qblocks, idx))
    o = o.transpose(1, 0, 3, 2, 4).reshape(bsz, seq, B_HEADS, B_V_DIM)
    o = rms_norm_f32(o, gsub) * (1.0 - lam_init)
    return o.reshape(bsz, seq, B_V_W)


def memory_cross_attn(h, m, wq, wkv, gq, gk, wo):
    bsz, seq, _ = h.shape
    q = rms_norm_f32((h @ wq).reshape(bsz, seq, C_HEADS, C_HEAD_DIM), gq)
    kv = (m @ wkv).reshape(bsz, m.shape[1], 2, C_HEADS, C_HEAD_DIM)
    k = rms_norm_f32(kv[:, :, 0], gk)
    v = kv[:, :, 1].astype(jnp.float32)
    s = jnp.einsum('bqhd,bkhd->bhqk', q, k) * (C_HEAD_DIM ** -0.5)
    p = jax.nn.softmax(s, axis=-1)
    o = jnp.einsum('bhqk,bkhd->bqhd', p, v).reshape(bsz, seq, C_WIDTH)
    return o.astype(h.dtype) @ wo


def trunk(x, mem, g_mix, w_in, ga_q, ga_k, gb_q, gb_k, lam_q1, lam_k1, lam_q2, lam_k2, gb_sub,
          w_out, g_cross, g_mem, wc_q, wc_kv, gc_q, gc_k, wc_o, g_ffn, w_gate_up, w_down):
    seq = x.shape[1]
    tables = axial_rope_tables(seq)
    cuts = np.cumsum([A_Q_W, A_KV_W, A_KV_W, B_QK_W, B_QK_W]).tolist()
    for l in range(DEPTH):
        lam_init = 0.8 - 0.6 * math.exp(-0.3 * l)
        h = rms_norm(x, g_mix[l])
        qa, ka, va, qb, kb, vb = jnp.split(h @ w_in[l], cuts, axis=-1)
        ya = gqa_axial(qa, ka, va, ga_q[l], ga_k[l], tables)
        yb = diff_alibi(qb, kb, vb, gb_q[l], gb_k[l], lam_q1[l], lam_k1[l], lam_q2[l], lam_k2[l],
                        gb_sub[l], lam_init)
        x = x + jnp.concatenate([ya, yb], axis=-1).astype(x.dtype) @ w_out[l]
        x = x + memory_cross_attn(rms_norm(x, g_cross[l]), rms_norm(mem, g_mem[l]),
                                  wc_q[l], wc_kv[l], gc_q[l], gc_k[l], wc_o[l])
        gate, up = jnp.split(rms_norm(x, g_ffn[l]) @ w_gate_up[l], 2, axis=-1)
        x = x + (jax.nn.silu(gate) * up) @ w_down[l]
    return x


def setup_inputs(seed: int = 0) -> dict:
    key = jax.random.key(seed)
    ks = jax.random.split(key, 32)
    f32 = jnp.float32

    def nrm(k, shape, scale):
        return jax.random.normal(k, shape, f32) * scale

    def gain(k, n):
        return 1.0 + 0.02 * jax.random.normal(k, (DEPTH, n), f32)

    return {
        "x_prompt": nrm(ks[0], (BATCH, SEQ, D_MODEL), 1.0),
        "x_sample": nrm(ks[1], (DEC_BATCH, DEC_SEQ, D_MODEL), 1.0),
        "mem_prompt": nrm(ks[2], (BATCH, MEM_LEN, D_MODEL), 1.0),
        "mem_sample": nrm(ks[3], (DEC_BATCH, MEM_LEN, D_MODEL), 1.0),
        "g_mix": gain(ks[4], D_MODEL),
        "w_in": nrm(ks[5], (DEPTH, D_MODEL, IN_WIDTH), D_MODEL ** -0.5),
        "ga_q": gain(ks[6], HEAD_DIM),
        "ga_k": gain(ks[7], HEAD_DIM),
        "gb_q": gain(ks[8], HEAD_DIM),
        "gb_k": gain(ks[9], HEAD_DIM),
        "lam_q1": nrm(ks[10], (DEPTH, HEAD_DIM), 0.1),
        "lam_k1": nrm(ks[11], (DEPTH, HEAD_DIM), 0.1),
        "lam_q2": nrm(ks[12], (DEPTH, HEAD_DIM), 0.1),
        "lam_k2": nrm(ks[13], (DEPTH, HEAD_DIM), 0.1),
        "gb_sub": gain(ks[14], B_V_DIM),
        "w_out": nrm(ks[15], (DEPTH, MIX_WIDTH, D_MODEL), MIX_WIDTH ** -0.5),
        "g_cross": gain(ks[16], D_MODEL),
        "g_mem": gain(ks[17], D_MODEL),
        "wc_q": nrm(ks[18], (DEPTH, D_MODEL, C_WIDTH), D_MODEL ** -0.5),
        "wc_kv": nrm(ks[19], (DEPTH, D_MODEL, 2 * C_WIDTH), D_MODEL ** -0.5),
        "gc_q": gain(ks[20], C_HEAD_DIM),
        "gc_k": gain(ks[21], C_HEAD_DIM),
        "wc_o": nrm(ks[22], (DEPTH, C_WIDTH, D_MODEL), C_WIDTH ** -0.5),
        "g_ffn": gain(ks[23], D_MODEL),
        "w_gate_up": nrm(ks[24], (DEPTH, D_MODEL, 2 * D_FF), D_MODEL ** -0.5),
        "w_down": nrm(ks[25], (DEPTH, D_FF, D_MODEL), D_FF ** -0.5),
    }


def reference(x_prompt, x_sample, mem_prompt, mem_sample, g_mix, w_in, ga_q, ga_k, gb_q, gb_k,
              lam_q1, lam_k1, lam_q2, lam_k2, gb_sub, w_out, g_cross, g_mem, wc_q, wc_kv, gc_q, gc_k,
              wc_o, g_ffn, w_gate_up, w_down):
    y_prompt = trunk(x_prompt, mem_prompt, g_mix, w_in, ga_q, ga_k, gb_q, gb_k, lam_q1, lam_k1,
                     lam_q2, lam_k2, gb_sub, w_out, g_cross, g_mem, wc_q, wc_kv, gc_q, gc_k, wc_o,
                     g_ffn, w_gate_up, w_down)
    y_sample = trunk(x_sample, mem_sample, g_mix, w_in, ga_q, ga_k, gb_q, gb_k, lam_q1, lam_k1,
                     lam_q2, lam_k2, gb_sub, w_out, g_cross, g_mem, wc_q, wc_kv, gc_q, gc_k, wc_o,
                     g_ffn, w_gate_up, w_down)
    return (y_prompt, y_sample)
```

```cpp
#include <hip/hip_runtime.h>
#include <hip/hip_cooperative_groups.h>
#include <cstdio>
#include <cstdint>
namespace cg = cooperative_groups;

#define DI __device__ __forceinline__
typedef unsigned short bf16_t;
typedef short bf16x8 __attribute__((ext_vector_type(8)));
typedef float f32x16 __attribute__((ext_vector_type(16)));
typedef float f32x4 __attribute__((ext_vector_type(4)));
typedef float f32x2 __attribute__((ext_vector_type(2)));
typedef unsigned u32x4 __attribute__((ext_vector_type(4)));
typedef unsigned u32x2 __attribute__((ext_vector_type(2)));

constexpr int T = 32768, TP = 16384;
constexpr float LOG2E = 1.4426950408889634f;
constexpr float EPS = 1e-6f;
constexpr int NTHR = 512;
constexpr int SMEM_BYTES = 135168 + 1024;

constexpr int VTP = T + 64;
constexpr size_t CHS = (size_t)64 * VTP;
constexpr int KPAD = 64, LDH = 1024 + KPAD, LDCO = 512 + KPAD, LDACT = 2816 + KPAD;
constexpr size_t SZ_WIN = 2304ull * (1024 + KPAD) * 2, SZ_WOUT = 1024ull * (1024 + KPAD) * 2, SZ_WCQ = 512ull * (1024 + KPAD) * 2, SZ_WCKV = 1024ull * (1024 + KPAD) * 2,
                 SZ_WCO = 1024ull * (512 + KPAD) * 2, SZ_WGU = 5632ull * (1024 + KPAD) * 2, SZ_WDN = 1024ull * (2816 + KPAD) * 2;
constexpr size_t OFF_WIN = 0, OFF_WOUT = OFF_WIN + SZ_WIN, OFF_WCQ = OFF_WOUT + SZ_WOUT, OFF_WCKV = OFF_WCQ + SZ_WCQ, OFF_WCO = OFF_WCKV + SZ_WCKV,
                 OFF_WGU = OFF_WCO + SZ_WCO, OFF_WDN = OFF_WGU + SZ_WGU, SZ_WLAYER = OFF_WDN + SZ_WDN;
constexpr size_t OFF_HB = 2 * SZ_WLAYER;
constexpr size_t OFF_MEMHB = OFF_HB + (size_t)T * LDH * 2;
constexpr size_t SZ_MEMK = 4ull * 1536 * 128 * 2;
constexpr size_t OFF_MEMK = OFF_MEMHB + 1536ull * LDH * 2;
constexpr size_t OFF_MEMVT = OFF_MEMK + 2 * SZ_MEMK;
constexpr size_t OFF_ROPE = OFF_MEMVT + 2 * SZ_MEMK;
constexpr size_t OFF_SCAL = OFF_ROPE + 128 * 16 * 8;
constexpr size_t OFF_BAR = OFF_SCAL + 256;
constexpr size_t OFF_R = OFF_BAR + 16384;
constexpr size_t OFF_XB = OFF_R + (size_t)T * LDACT * 2;
constexpr size_t OFF_SSP = OFF_XB + (size_t)T * LDH * 2;
constexpr size_t WS_NEED = OFF_SSP + (size_t)T * 16 * 4;

struct Params {
  const float* xp; const float* xs; const float* memp; const float* mems;
  const float* g_mix; const float* w_in; const float* ga_q; const float* ga_k; const float* gb_q; const float* gb_k;
  const float* lq1; const float* lk1; const float* lq2; const float* lk2; const float* gb_sub;
  const float* w_out; const float* g_cross; const float* g_mem; const float* wc_q; const float* wc_kv; const float* gc_q; const float* gc_k;
  const float* wc_o; const float* g_ffn; const float* w_gu; const float* w_dn;
  float* out; char* ws;
  int ph0; int ph1;
};

struct Params;
DI const Params* kargs() { unsigned long long kp = (unsigned long long)__builtin_amdgcn_kernarg_segment_ptr(); asm volatile("" : "+s"(kp)); return (const Params*)kp; }
DI int opaque_tid() {
  const int w = __builtin_amdgcn_readfirstlane((int)threadIdx.x >> 6);
  int t = (w << 6) | (int)__builtin_amdgcn_mbcnt_hi(~0u, __builtin_amdgcn_mbcnt_lo(~0u, 0u));
  asm volatile("" : "+v"(t)); return t; }
typedef __bf16 bf16x2_t __attribute__((ext_vector_type(2)));
DI unsigned cvt_pk(float lo, float hi) { f32x2 f = {lo, hi}; return __builtin_bit_cast(unsigned, __builtin_convertvector(f, bf16x2_t)); }
DI void st8(void* p, u32x2 v) { __hip_atomic_store((unsigned long long*)p, __builtin_bit_cast(unsigned long long, v), __ATOMIC_RELAXED, __HIP_MEMORY_SCOPE_AGENT); }
DI int crow(int i, int h) { return (i & 3) + 8 * (i >> 2) + 4 * h; }
template <int CTRL> DI float dppf(float v) { return __builtin_bit_cast(float, __builtin_amdgcn_update_dpp(0, __builtin_bit_cast(int, v), CTRL, 0xF, 0xF, true)); }
DI float rdlane(float v, int l) { return __builtin_bit_cast(float, __builtin_amdgcn_readlane(__builtin_bit_cast(int, v), l)); }
DI float wave_sum(float v) {
  v += dppf<0xB1>(v); v += dppf<0x4E>(v); v += dppf<0x141>(v); v += dppf<0x140>(v);
  return (rdlane(v, 0) + rdlane(v, 16)) + (rdlane(v, 32) + rdlane(v, 48));
}
DI float wave_max(float v) {
  v = fmaxf(v, dppf<0xB1>(v)); v = fmaxf(v, dppf<0x4E>(v)); v = fmaxf(v, dppf<0x141>(v)); v = fmaxf(v, dppf<0x140>(v));
  return fmaxf(fmaxf(rdlane(v, 0), rdlane(v, 16)), fmaxf(rdlane(v, 32), rdlane(v, 48)));
}
DI float half_sum(float x) {
  int idx = (int)((__builtin_amdgcn_mbcnt_hi(~0u, __builtin_amdgcn_mbcnt_lo(~0u, 0u)) ^ 32u) << 2);
  asm volatile("" : "+v"(idx));
  return x + __builtin_bit_cast(float, __builtin_amdgcn_ds_bpermute(idx, __builtin_bit_cast(int, x)));
}
DI int seqpos(int t) { return t < TP ? (t & 8191) : (t & 4095); }
DI f32x16 zero16() { f32x16 z; for (int i = 0; i < 16; ++i) z[i] = 0.f; return z; }
#define MFMA32(a, b, c) __builtin_amdgcn_mfma_f32_32x32x16_bf16((a), (b), (c), 0, 0, 0)

constexpr int GSTG = 32768;
constexpr int GEMM_XCH = 4 * GSTG;

DI void glds16(const void* g, char* l) { __builtin_amdgcn_global_load_lds((const unsigned*)g, (__attribute__((address_space(3))) unsigned*)l, 16, 0, 0); }
#define WAIT_VM0() asm volatile("s_waitcnt vmcnt(0)" ::: "memory")
#define WAIT_VMN(n) asm volatile("s_waitcnt vmcnt(" #n ") lgkmcnt(0)" ::: "memory")

template <class Epi>
DI void gemm_phase(const bf16_t* __restrict__ A, int lda, const bf16_t* __restrict__ Bt, int ldb, int M, int N, int K, char* smem, const Epi& epi) {
  const int tid = opaque_tid(), lane = tid & 63, w = tid >> 6;
  const int wm = w & 1, wn = w >> 1, r = lane & 31, h = lane >> 5;
  const int nN = N >> 8, nM = M >> 8, nk = K >> 5;
  const bool xcd = ((nM & 7) == 0) && ((gridDim.x & 7) == 0);
  const int first = xcd ? (int)(blockIdx.x >> 3) : (int)blockIdx.x, stride = xcd ? (int)(gridDim.x >> 3) : (int)gridDim.x, tot = xcd ? (nM >> 3) * nN : nM * nN;
  const int ntl = first < tot ? (tot - first + stride - 1) / stride : 0;
  if (ntl == 0) return;
#define TILE_MN(i, m0, n0) do { const int j_ = first + (i) * stride; const int q_ = j_ / nN; (n0) = (j_ - q_ * nN) << 8; (m0) = (xcd ? (int)(blockIdx.x & 7) + 8 * q_ : q_) << 8; } while (0)
  unsigned ga[2], gb[2];
#pragma unroll
  for (int i = 0; i < 2; ++i) {
    const int row = (w + 8 * i) * 16 + (lane >> 2), j = (lane & 3) ^ ((row >> 2) & 3);
    ga[i] = (unsigned)(row * lda + j * 8);
    gb[i] = (unsigned)(row * ldb + j * 8);
  }
  char* ldsw = smem + w * 1024 + lane * 16;
  const int sw = (r >> 2) & 3;
  const int a_off = (wm * 128 + r) * 64 + ((h ^ (sw & 1)) << 4);
  const int b_off = 16384 + (wn * 64 + r) * 64 + ((h ^ (sw & 1)) << 4);
  const int swz = (sw & 2) << 4;
  const int nk2 = nk >> 1, G = ntl * nk2;
  int it_i = 0, it_k = 0;
  const bf16_t* iA; const bf16_t* iB;
  { int m0, n0; TILE_MN(0, m0, n0); iA = A + (size_t)m0 * lda; iB = Bt + (size_t)n0 * ldb; }
#define ISSUE_PART(step, part) do { char* d_ = ldsw + ((step) & 1) * 2 * GSTG + ((part) >> 1) * GSTG + ((part) & 1) * 16384; \
    const bf16_t* s_ = (((part) & 1) ? iB : iA) + it_k * 64 + ((part) >> 1) * 32; const unsigned* o_ = ((part) & 1) ? gb : ga; \
    glds16(s_ + o_[0], d_); glds16(s_ + o_[1], d_ + 8192); } while (0)
#define ISSUE_ADV() do { if (++it_k == nk2) { it_k = 0; ++it_i; if (it_i < ntl) { int m0_, n0_; TILE_MN(it_i, m0_, n0_); iA = A + (size_t)m0_ * lda; iB = Bt + (size_t)n0_ * ldb; } } } while (0)
#define ISSUE(step) do { ISSUE_PART(step, 0); ISSUE_PART(step, 1); ISSUE_PART(step, 2); ISSUE_PART(step, 3); ISSUE_ADV(); } while (0)
#define LOADF(bf, af, rr) do { const char* s_ = sp + ((rr) >> 1) * GSTG + ((((rr) & 1) * 32) ^ swz); \
    _Pragma("unroll") for (int tn = 0; tn < 2; ++tn) bf[tn] = *(const bf16x8*)(s_ + b_off + tn * 2048); \
    _Pragma("unroll") for (int tm = 0; tm < 4; ++tm) af[tm] = *(const bf16x8*)(s_ + a_off + tm * 2048); } while (0)
#define MMAS(bf, af) do { \
    _Pragma("unroll") for (int tn = 0; tn < 2; ++tn) _Pragma("unroll") for (int tm = 0; tm < 4; ++tm) acc[tn][tm] = MFMA32(bf[tn], af[tm], acc[tn][tm]); \
    } while (0)
  __syncthreads();
  ISSUE(0);
  f32x16 acc[2][4];
#pragma unroll
  for (int a = 0; a < 2; ++a)
#pragma unroll
    for (int b = 0; b < 4; ++b) acc[a][b] = zero16();
  int ct_i = 0, ct_k = 0;
  if (__builtin_amdgcn_readfirstlane(w) >= 4) __builtin_amdgcn_s_setprio(1);
  const bool early = w < 4;
#pragma unroll 1
  for (int g = 0; g < G; ++g) {
    WAIT_VMN(0);
    __builtin_amdgcn_s_barrier();
    const bool more = g + 1 < G;
    const char* sp = smem + (g & 1) * 2 * GSTG;
    bf16x8 bf0[2], af0[4], bf1[2], af1[4];
    LOADF(bf0, af0, 0);
    LOADF(bf1, af1, 1);
    if (more) ISSUE_PART(g + 1, 0);
    MMAS(bf0, af0);
    LOADF(bf0, af0, 2);
    if (more) ISSUE_PART(g + 1, 1);
    MMAS(bf1, af1);
    LOADF(bf1, af1, 3);
    if (more) ISSUE_PART(g + 1, 2);
    MMAS(bf0, af0);
    if (more) { ISSUE_PART(g + 1, 3); ISSUE_ADV(); }
    MMAS(bf1, af1);
    if (++ct_k == nk2) {
      ct_k = 0;
      int m0, n0; TILE_MN(ct_i, m0, n0); ++ct_i;
      if (Epi::STAGED) __syncthreads();
      epi(acc, m0 + wm * 128, n0 + wn * 64, smem, smem + (g & 1) * 2 * GSTG + w * 8192);
#pragma unroll
      for (int a = 0; a < 2; ++a)
#pragma unroll
        for (int b = 0; b < 4; ++b) acc[a][b] = zero16();
    }
  }
  __builtin_amdgcn_s_setprio(0);
  WAIT_VMN(0);
  __syncthreads();
#undef LOADF
#undef MMAS
#undef ISSUE
#undef ISSUE_PART
#undef ISSUE_ADV
#undef TILE_MN
}

DI float row_rstd(const float* ssp, int t) {
  const f32x4* q = (const f32x4*)(ssp + (size_t)t * 16);
  const f32x4 a = q[0], b = q[1], c = q[2], d = q[3];
  const float s = ((a.x + a.y) + (a.z + a.w)) + ((b.x + b.y) + (b.z + b.w)) + ((c.x + c.y) + (c.z + c.w)) + ((d.x + d.y) + (d.z + d.w));
  return rsqrtf(s * (1.f / 1024.f) + EPS);
}
struct EpiQKV {
  static constexpr bool STAGED = false;
  bf16_t* qkv; const float* gaq; const float* gak; const float* gbq; const float* gbk; const f32x2* rope; const float* ssp;
  DI void operator()(f32x16 (&acc)[2][4], int mb, int nb, char*, char*) const {
    const int tid_ = opaque_tid(), lane = tid_ & 63, c = lane & 31, h = lane >> 5;
    const int chunk = nb >> 6;
    int kind; const float* g = gaq;
    if (chunk < 8) { kind = 0; g = gaq; } else if (chunk < 10) { kind = 1; g = gak; } else if (chunk < 12) { kind = 2; }
    else if (chunk < 20) { kind = 3; g = gbq; } else if (chunk < 28) { kind = 4; g = gbk; } else { kind = 2; }
    bf16_t* dst = qkv + (size_t)chunk * CHS;
    if (kind == 2) {
#pragma unroll
      for (int tm = 0; tm < 4; ++tm) {
        const int t = mb + tm * 32 + c;
        const float rstd = row_rstd(ssp, t);
#pragma unroll
        for (int tn = 0; tn < 2; ++tn)
#pragma unroll
          for (int i = 0; i < 16; i += 2) {
            const unsigned pk = cvt_pk(acc[tn][tm][i] * rstd, acc[tn][tm][i + 1] * rstd);
            dst[(size_t)(tn * 32 + crow(i, h)) * VTP + t] = (bf16_t)(pk & 0xffff);
            dst[(size_t)(tn * 32 + crow(i + 1, h)) * VTP + t] = (bf16_t)(pk >> 16);
          }
      }
      return;
    }
    const bool dorope = kind <= 1, isq = (kind == 0 || kind == 3);
    const float qmul = isq ? 0.125f * LOG2E : 1.f;
#pragma unroll
    for (int tm = 0; tm < 4; ++tm) {
      __builtin_amdgcn_sched_barrier(0);
      const int t = mb + tm * 32 + c;
      const float rstd = row_rstd(ssp, t);
      float ss = 0.f;
#pragma unroll
      for (int tn = 0; tn < 2; ++tn)
#pragma unroll
        for (int i = 0; i < 16; ++i) { acc[tn][tm][i] *= rstd; ss += acc[tn][tm][i] * acc[tn][tm][i]; }
      ss = half_sum(ss);
      const float rs = rsqrtf(ss * (1.f / 64.f) + EPS);
#pragma unroll
      for (int tn = 0; tn < 2; ++tn)
#pragma unroll
        for (int g4 = 0; g4 < 4; ++g4) {
          const f32x4 gv = *(const f32x4*)(g + tn * 32 + 8 * g4 + 4 * h);
          acc[tn][tm][4 * g4] *= rs * gv.x; acc[tn][tm][4 * g4 + 1] *= rs * gv.y; acc[tn][tm][4 * g4 + 2] *= rs * gv.z; acc[tn][tm][4 * g4 + 3] *= rs * gv.w;
        }
      if (dorope) {
        const int pos = seqpos(t);
#pragma unroll
        for (int tn = 0; tn < 2; ++tn) {
          __builtin_amdgcn_sched_barrier(0);
          const int pp = tn == 0 ? (pos >> 6) : (pos & 63);
#pragma unroll
          for (int i = 0; i < 8; ++i) {
            const int j = (i & 3) + 4 * h + 8 * (i >> 2);
            const f32x2 cs = rope[pp * 16 + j];
            const float x1 = acc[tn][tm][i], x2 = acc[tn][tm][i + 8];
            acc[tn][tm][i] = x1 * cs.x - x2 * cs.y;
            acc[tn][tm][i + 8] = x2 * cs.x + x1 * cs.y;
          }
        }
      }
#pragma unroll
      for (int tn = 0; tn < 2; ++tn)
#pragma unroll
        for (int g4 = 0; g4 < 4; ++g4) {
          u32x2 pk;
          pk.x = cvt_pk(acc[tn][tm][4 * g4] * qmul, acc[tn][tm][4 * g4 + 1] * qmul);
          pk.y = cvt_pk(acc[tn][tm][4 * g4 + 2] * qmul, acc[tn][tm][4 * g4 + 3] * qmul);
          st8(dst + (size_t)t * 64 + tn * 32 + 8 * g4 + 4 * h, pk);
        }
    }
  }
};

struct EpiResid {
  static constexpr bool STAGED = true;
  bf16_t* xb; float* ssp; float* out;
  DI void operator()(f32x16 (&acc)[2][4], int mb, int nb, char*, char* stg) const {
    const int tid_ = opaque_tid(), lane = tid_ & 63, c = lane & 31, h = lane >> 5;
    const int rsub = lane >> 4, ch = lane & 15;
#pragma unroll
    for (int tm = 0; tm < 4; ++tm) {
#pragma unroll
      for (int tn = 0; tn < 2; ++tn)
#pragma unroll
        for (int g4 = 0; g4 < 4; ++g4) {
          const int k = tn * 8 + 2 * g4 + h;
          f32x4 v; v.x = acc[tn][tm][4 * g4]; v.y = acc[tn][tm][4 * g4 + 1]; v.z = acc[tn][tm][4 * g4 + 2]; v.w = acc[tn][tm][4 * g4 + 3];
          *(f32x4*)(stg + c * 256 + ((k ^ (c & 15)) << 4)) = v;
        }
#pragma unroll
      for (int kk = 0; kk < 8; ++kk) {
        const int rr = 4 * kk + rsub;
        const f32x4 v = *(const f32x4*)(stg + rr * 256 + ((ch ^ (rr & 15)) << 4));
        const int t = mb + tm * 32 + rr, n = nb + ch * 4;
        bf16_t* xp_ = xb + (size_t)t * LDH + n;
        const u32x2 xr = *(const u32x2*)xp_;
        f32x4 rv;
        rv.x = __uint_as_float(xr.x << 16) + v.x; rv.y = __uint_as_float(xr.x & 0xffff0000u) + v.y;
        rv.z = __uint_as_float(xr.y << 16) + v.z; rv.w = __uint_as_float(xr.y & 0xffff0000u) + v.w;
        u32x2 pk; pk.x = cvt_pk(rv.x, rv.y); pk.y = cvt_pk(rv.z, rv.w);
        st8(xp_, pk);
        if (out) *(f32x4*)(out + (size_t)t * 1024 + n) = rv;
        float ss = (rv.x * rv.x + rv.y * rv.y) + (rv.z * rv.z + rv.w * rv.w);
        ss += dppf<0xB1>(ss); ss += dppf<0x4E>(ss); ss += dppf<0x141>(ss); ss += dppf<0x140>(ss);
        if (ch == 0) ssp[(size_t)t * 16 + (nb >> 6)] = ss;
      }
    }
  }
};

struct EpiN128 {
  static constexpr bool STAGED = false;
  bf16_t* dstK; size_t kHeadStride; int kRowStride; const float* gain; float mul; int nsplit; bf16_t* dstVt; int vtld; const float* ssp;
  DI void operator()(f32x16 (&acc)[2][4], int mb, int nb, char* smem, char*) const {
    const int tid_ = opaque_tid(), lane = tid_ & 63, c = lane & 31, h = lane >> 5, w = tid_ >> 6;
    float* xch = (float*)(smem + GEMM_XCH);
    if (nb >= nsplit) {
      const int nv = nb - nsplit;
#pragma unroll
      for (int tm = 0; tm < 4; ++tm) {
        const int t = mb + tm * 32 + c;
#pragma unroll
        for (int tn = 0; tn < 2; ++tn)
#pragma unroll
          for (int i = 0; i < 16; i += 2) {
            const unsigned pk = cvt_pk(acc[tn][tm][i], acc[tn][tm][i + 1]);
            dstVt[(size_t)(nv + tn * 32 + crow(i, h)) * vtld + t] = (bf16_t)(pk & 0xffff);
            dstVt[(size_t)(nv + tn * 32 + crow(i + 1, h)) * vtld + t] = (bf16_t)(pk >> 16);
          }
      }
      return;
    }
    float ssv[4];
#pragma unroll
    for (int tm = 0; tm < 4; ++tm) {
      if (ssp) { const float rstd = row_rstd(ssp, mb + tm * 32 + c);
#pragma unroll
        for (int tn = 0; tn < 2; ++tn)
#pragma unroll
          for (int i = 0; i < 16; ++i) acc[tn][tm][i] *= rstd; }
      float ss = 0.f;
#pragma unroll
      for (int tn = 0; tn < 2; ++tn)
#pragma unroll
        for (int i = 0; i < 16; ++i) ss += acc[tn][tm][i] * acc[tn][tm][i];
      ss = half_sum(ss);
      ssv[tm] = ss;
      if (h == 0) xch[w * 128 + tm * 32 + c] = ss;
    }
    __syncthreads();
    const int head = nb >> 7, nin = nb & 127;
    bf16_t* dk = dstK + (size_t)head * kHeadStride;
#pragma unroll
    for (int tm = 0; tm < 4; ++tm) {
      const int t = mb + tm * 32 + c;
      const float ss = ssv[tm] + xch[(w ^ 2) * 128 + tm * 32 + c];
      const float rs = rsqrtf(ss * (1.f / 128.f) + EPS) * mul;
#pragma unroll
      for (int tn = 0; tn < 2; ++tn)
#pragma unroll
        for (int g4 = 0; g4 < 4; ++g4) {
          const int n = nin + tn * 32 + 8 * g4 + 4 * h;
          const f32x4 gv = *(const f32x4*)(gain + n);
          u32x2 pk;
          pk.x = cvt_pk(acc[tn][tm][4 * g4] * rs * gv.x, acc[tn][tm][4 * g4 + 1] * rs * gv.y);
          pk.y = cvt_pk(acc[tn][tm][4 * g4 + 2] * rs * gv.z, acc[tn][tm][4 * g4 + 3] * rs * gv.w);
          st8(dk + (size_t)t * kRowStride + n, pk);
        }
    }
    __syncthreads();
  }
};

struct EpiSwiGLU {
  static constexpr bool STAGED = false;
  bf16_t* act; const float* ssp;
  DI void operator()(f32x16 (&acc)[2][4], int mb, int nb, char*, char*) const {
    const int tid_ = opaque_tid(), lane = tid_ & 63, c = lane & 31, h = lane >> 5;
    const int jb = (nb >> 6) * 32;
#pragma unroll
    for (int tm = 0; tm < 4; ++tm) {
      const int t = mb + tm * 32 + c;
      const float rstd = row_rstd(ssp, t);
#pragma unroll
      for (int g4 = 0; g4 < 4; ++g4) {
        float o[4];
#pragma unroll
        for (int e = 0; e < 4; ++e) {
          const float gt = acc[0][tm][4 * g4 + e] * rstd, up = acc[1][tm][4 * g4 + e] * rstd;
          o[e] = gt * __builtin_amdgcn_rcpf(1.f + __builtin_amdgcn_exp2f(-gt * LOG2E)) * up;
        }
        u32x2 pk; pk.x = cvt_pk(o[0], o[1]); pk.y = cvt_pk(o[2], o[3]);
        st8(act + (size_t)t * LDACT + jb + 8 * g4 + 4 * h, pk);
      }
    }
  }
};

DI void norm_rows(const float* src0, const float* src1, int split, int nrows, bf16_t* dst, float* ssp) {
  const int tid_ = opaque_tid(), lane = tid_ & 63, w = tid_ >> 6;
  for (int row = blockIdx.x * 8 + w; row < nrows; row += gridDim.x * 8) {
    const float* p = row < split ? src0 + (size_t)row * 1024 : src1 + (size_t)(row - split) * 1024;
    f32x4 v[4];
#pragma unroll
    for (int i = 0; i < 4; ++i) v[i] = *(const f32x4*)(p + i * 256 + lane * 4);
    float ss = 0.f;
#pragma unroll
    for (int i = 0; i < 4; ++i) ss += v[i].x * v[i].x + v[i].y * v[i].y + v[i].z * v[i].z + v[i].w * v[i].w;
    ss = wave_sum(ss);
    const float rs = ssp ? 1.f : rsqrtf(ss * (1.f / 1024.f) + EPS);
    if (ssp && lane < 16) ssp[(size_t)row * 16 + lane] = lane == 0 ? ss : 0.f;
#pragma unroll
    for (int i = 0; i < 4; ++i) {
      u32x2 pk; pk.x = cvt_pk(v[i].x * rs, v[i].y * rs); pk.y = cvt_pk(v[i].z * rs, v[i].w * rs);
      st8(dst + (size_t)row * LDH + i * 256 + lane * 4, pk);
    }
  }
}

DI void convert_w(const float* __restrict__ W, const float* __restrict__ g, bf16_t* __restrict__ Wt, int K, int N, int mode, char* smem, int& rot) {
  float* s = (float*)smem;
  const int tid = opaque_tid();
  const int nkt = K >> 6, nnt = N >> 6, nt = nkt * nnt;
  int start = (int)blockIdx.x - rot; if (start < 0) start += gridDim.x;
  for (int tile = start; tile < nt; tile += gridDim.x) {
    const int k0 = (tile / nnt) << 6, n0 = (tile % nnt) << 6;
    {
      const int row = tid >> 3, col = (tid & 7) * 8;
      const float gg = g ? g[k0 + row] : 1.f;
      const f32x4 a = *(const f32x4*)(W + (size_t)(k0 + row) * N + n0 + col);
      const f32x4 b = *(const f32x4*)(W + (size_t)(k0 + row) * N + n0 + col + 4);
      float* d = s + row * 65 + col;
      d[0] = a.x * gg; d[1] = a.y * gg; d[2] = a.z * gg; d[3] = a.w * gg; d[4] = b.x * gg; d[5] = b.y * gg; d[6] = b.z * gg; d[7] = b.w * gg;
    }
    __syncthreads();
    {
      const int n = tid >> 3, kc = (tid & 7) * 8;
      int nn = n0 + n;
      if (mode == 1) { if (nn < 2816) nn = (nn >> 5) * 64 + (nn & 31); else { const int j = nn - 2816; nn = (j >> 5) * 64 + 32 + (j & 31); } }
      u32x4 pk;
      pk.x = cvt_pk(s[(kc + 0) * 65 + n], s[(kc + 1) * 65 + n]); pk.y = cvt_pk(s[(kc + 2) * 65 + n], s[(kc + 3) * 65 + n]);
      pk.z = cvt_pk(s[(kc + 4) * 65 + n], s[(kc + 5) * 65 + n]); pk.w = cvt_pk(s[(kc + 6) * 65 + n], s[(kc + 7) * 65 + n]);
      *(u32x4*)(Wt + (size_t)nn * (K + KPAD) + k0 + kc) = pk;
    }
    __syncthreads();
  }
  rot = (rot + nt) % (int)gridDim.x;
}

__device__ const double kInvFreq[16] = {1.0, 0.5623413251903491, 0.31622776601683794, 0.1778279410038923, 0.1, 0.05623413251903491, 0.031622776601683794,
                                        0.01778279410038923, 0.01, 0.005623413251903491, 0.0031622776601683794, 0.001778279410038923, 0.001,
                                        0.0005623413251903491, 0.00031622776601683794, 0.0001778279410038923};
DI void rope_table(f32x2* tab) {
  const int idx = blockIdx.x * NTHR + threadIdx.x;
  if (idx < 2048) {
    const int pidx = idx >> 4, j = idx & 15;
    const double th = (double)pidx * kInvFreq[j];
    const double twopi = 6.283185307179586476925;
    const double kk = rint(th / twopi);
    const double r = th - kk * twopi, r2 = r * r;
    double ts = r, tc = 1.0, sn = r, cs = 1.0;
    for (int n = 1; n <= 15; ++n) { tc *= -r2 / (double)((2 * n - 1) * (2 * n)); cs += tc; ts *= -r2 / (double)((2 * n) * (2 * n + 1)); sn += ts; }
    f32x2 o; o.x = (float)cs; o.y = (float)sn; tab[idx] = o;
  }
}

template <int D, int DV, int QT, int NK, bool ALIBI, int QL>
DI void attn_core(const bf16_t* __restrict__ qbase, int qstride, const bf16_t* __restrict__ kbase, size_t kmapstride, const bf16_t* __restrict__ vtbase, size_t vtstride,
                  int kt0, int kt1, int kmap, float shift, float slope, int qpos0, char* smem, f32x16 (&O)[QT][DV / 32], float (&linv)[QT]) {
  constexpr int KROW = D * 2, KBYTES = NK * 64 * KROW, VBYTES = DV * 128, STAGE = KBYTES + VBYTES;
  constexpr int NKI = KBYTES / 8192, NVI = VBYTES / 8192;
  const int tid = opaque_tid(), lane = tid & 63, w = tid >> 6;
  const int c = lane & 31, h = lane >> 5;
  bf16x8 qf[QT - QL > 0 ? QT - QL : 1][D / 16];
  char* qlds = smem + 2 * STAGE + w * (QL * (D / 16) * 1024) + lane * 16;
  __syncthreads();
#pragma unroll
  for (int qt = 0; qt < QT; ++qt)
#pragma unroll
    for (int ks = 0; ks < D / 16; ++ks) {
      const bf16x8 q = *(const bf16x8*)(qbase + (size_t)(qt * 32 + c) * qstride + ks * 16 + 8 * h);
      if (qt < QT - QL) qf[qt][ks] = q; else *(bf16x8*)(qlds + ((qt - (QT - QL)) * (D / 16) + ks) * 1024) = q;
    }
#pragma unroll
  for (int qt = 0; qt < QT; ++qt) {
    linv[qt] = 0.f;
#pragma unroll
    for (int d = 0; d < DV / 32; ++d) O[qt][d] = zero16();
  }
  unsigned ksrc[NKI], vsrc[NVI];
#pragma unroll
  for (int i = 0; i < NKI; ++i) {
    const int blk = w + 8 * i;
    if (D == 64) {
      const int row = blk * 8 + (lane >> 3), j = (lane & 7) ^ ((row >> 1) & 7);
      ksrc[i] = (unsigned)((row >> 6) * (int)kmapstride + (row & 63) * 64 + j * 8);
    } else {
      const int row = blk * 4 + (lane >> 4), j = (lane & 15) ^ (row & 15);
      ksrc[i] = (unsigned)(row * 128 + j * 8);
    }
  }
#pragma unroll
  for (int i = 0; i < NVI; ++i) {
    const int row = (w + 8 * i) * 8 + (lane >> 3), j = (lane & 7) ^ ((row >> 1) & 7);
    vsrc[i] = (unsigned)(row * (int)vtstride + j * 8);
  }
  char* ldsw = smem + w * 1024 + lane * 16;
  WAIT_VM0();
  __syncthreads();
#pragma unroll
  for (int i = 0; i < NKI; ++i) glds16(kbase + (size_t)kt0 * 64 * D + ksrc[i], ldsw + (kt0 & 1) * STAGE + i * 8192);
#pragma unroll
  for (int i = 0; i < NVI; ++i) glds16(vtbase + kt0 * 64 + vsrc[i], ldsw + (kt0 & 1) * STAGE + KBYTES + i * 8192);
  WAIT_VM0();
  __syncthreads();
  const int pr = (c & 0x13) | ((c & 4) << 1) | ((c & 8) >> 1);
  int koff, kswz;
  if (D == 64) { const int sw = (pr >> 1) & 7; koff = (kmap * 64 + pr) * KROW + ((h ^ (sw & 1)) << 4); kswz = (sw & 6) << 4; }
  else { const int sw = pr & 15; koff = pr * KROW + ((h ^ (sw & 1)) << 4); kswz = (sw & 14) << 4; }
  const int vsw = (c >> 1) & 7;
  const int voff = KBYTES + c * 128 + ((h ^ (vsw & 1)) << 4), vswz = (vsw & 6) << 4;
  const float nshift = -shift;
  const float lanebase = (float)(8 * h - qpos0 - c);
  if (__builtin_amdgcn_readfirstlane(w) >= 4) __builtin_amdgcn_s_setprio(1);
#pragma unroll 1
  for (int kt = kt0; kt < kt1; ++kt) {
    const char* sb = smem + (kt & 1) * STAGE;
#pragma unroll
    for (int kk = 0; kk < 2; ++kk) {
      bf16x8 pf[QT][2];
      {
        f32x16 S[QT];
#pragma unroll
        for (int qt = 0; qt < QT; ++qt) {
          if (ALIBI) {
            const float dbase = lanebase + (float)(kt * 64 + kk * 32 - qt * 32);
            const int kb_ = kt * 64 + kk * 32, qb_ = qpos0 + qt * 32;
            if (kb_ >= qb_ + 31 || kb_ + 31 <= qb_) {
              const float sl = kb_ >= qb_ + 31 ? -slope : slope;
              const float b0 = __builtin_fmaf(sl, dbase, nshift);
#pragma unroll
              for (int i = 0; i < 16; ++i) S[qt][i] = __builtin_fmaf(sl, (float)(16 * (i >> 3) + (i & 7)), b0);
            } else {
#pragma unroll
              for (int i = 0; i < 16; ++i) S[qt][i] = __builtin_fmaf(-slope, __builtin_fabsf(dbase + (float)(16 * (i >> 3) + (i & 7))), nshift);
            }
          } else {
            S[qt] = zero16();
          }
        }
#pragma unroll
        for (int ks = 0; ks < D / 16; ++ks) {
          const bf16x8 kf = *(const bf16x8*)(sb + koff + kk * 32 * KROW + ((ks * 32) ^ kswz));
#pragma unroll
          for (int qt = 0; qt < QT; ++qt) {
            if (qt < QT - QL) S[qt] = MFMA32(kf, qf[qt][ks], S[qt]);
            else S[qt] = MFMA32(kf, *(const bf16x8*)(qlds + ((qt - (QT - QL)) * (D / 16) + ks) * 1024), S[qt]);
          }
        }
#pragma unroll
        for (int qt = 0; qt < QT; ++qt)
#pragma unroll
          for (int s = 0; s < 2; ++s) {
            float e[8];
#pragma unroll
            for (int j = 0; j < 8; ++j) { e[j] = __builtin_amdgcn_exp2f(S[qt][8 * s + j]); linv[qt] += e[j]; }
            u32x4 pk; pk.x = cvt_pk(e[0], e[1]); pk.y = cvt_pk(e[2], e[3]); pk.z = cvt_pk(e[4], e[5]); pk.w = cvt_pk(e[6], e[7]);
            pf[qt][s] = __builtin_bit_cast(bf16x8, pk);
          }
      }
#pragma unroll
      for (int d = 0; d < DV / 32; ++d)
#pragma unroll
        for (int s = 0; s < 2; ++s) {
          const bf16x8 vf = *(const bf16x8*)(sb + voff + d * 4096 + (((kk * 4 + s * 2) * 16) ^ vswz));
#pragma unroll
          for (int qt = 0; qt < QT; ++qt) O[qt][d] = MFMA32(vf, pf[qt][s], O[qt][d]);
        }
      if (kk == 0) {
      if (kt + 1 < kt1) {
        char* d = ldsw + ((kt + 1) & 1) * STAGE;
        const bf16_t* kb2 = kbase + (size_t)(kt + 1) * 64 * D; const bf16_t* vb2 = vtbase + (kt + 1) * 64;
#pragma unroll
        for (int i = 0; i < NKI; ++i) glds16(kb2 + ksrc[i], d + i * 8192);
#pragma unroll
        for (int i = 0; i < NVI; ++i) glds16(vb2 + vsrc[i], d + KBYTES + i * 8192);
      }
      }
    }
    WAIT_VM0();
    __syncthreads();
  }
  __builtin_amdgcn_s_setprio(0);
#pragma unroll
  for (int qt = 0; qt < QT; ++qt) { float l = linv[qt]; l = half_sum(l); linv[qt] = 1.f / l; }
}

DI float gain_bound(const float* g, int n) {
  const int lane = opaque_tid() & 63;
  float m = fabsf(g[lane]);
  if (n > 64) m = fmaxf(m, fabsf(g[64 + lane]));
  return wave_max(m);
}

DI void attn_a_item(const bf16_t* qkv, bf16_t* outp, int seq_tok0, int S, int kvh, int qb, float shift, char* smem) {
  const int tid_ = opaque_tid(), w = tid_ >> 6, lane = tid_ & 63, c = lane & 31, h = lane >> 5;
  const int hd = kvh * 4 + (w & 3), qrow0 = seq_tok0 + qb * 128 + (w >> 2) * 64;
  f32x16 O[2][2]; float linv[2];
  attn_core<64, 64, 2, 1, false, 0>(qkv + (size_t)hd * CHS + (size_t)qrow0 * 64, 64, qkv + (size_t)(8 + kvh) * CHS + (size_t)seq_tok0 * 64, 0,
                                 qkv + (size_t)(10 + kvh) * CHS + seq_tok0, VTP, 0, S >> 6, 0, shift, 0.f, 0, smem, O, linv);
  const int tid2 = opaque_tid(), w2 = tid2 >> 6, c2 = tid2 & 31, h2 = (tid2 >> 5) & 1;
  const int hd2 = kvh * 4 + (w2 & 3), qrow2 = seq_tok0 + qb * 128 + (w2 >> 2) * 64;
#pragma unroll
  for (int qt = 0; qt < 2; ++qt) {
    const int t = qrow2 + qt * 32 + c2;
#pragma unroll
    for (int d = 0; d < 2; ++d)
#pragma unroll
      for (int g4 = 0; g4 < 4; ++g4) {
        u32x2 pk;
        pk.x = cvt_pk(O[qt][d][4 * g4] * linv[qt], O[qt][d][4 * g4 + 1] * linv[qt]);
        pk.y = cvt_pk(O[qt][d][4 * g4 + 2] * linv[qt], O[qt][d][4 * g4 + 3] * linv[qt]);
        st8(outp + (size_t)t * LDH + hd2 * 64 + d * 32 + 8 * g4 + 4 * h2, pk);
      }
  }
}

DI void attn_b_item(const bf16_t* qkv, bf16_t* outp, int seq_tok0, int S, int head, int qb, const float* scal, const float* gsub, char* smem) {
  const int tid_ = opaque_tid(), w = tid_ >> 6;
  const int map = w & 1, qp = w >> 1, qpos0 = qb * 128 + qp * 32, qrow0 = seq_tok0 + qpos0;
  const float slope = exp2f(-2.f * (float)(head + 1)) * LOG2E;
  const float shift = scal[1];
  const float wf = fminf((150.f + 2.f * shift) / slope + 1.f, 65536.f);
  const int W = __builtin_amdgcn_readfirstlane((int)wf);
  int kt0 = (qb * 128 - W) >> 6; if (kt0 < 0) kt0 = 0;
  int kt1 = ((qb * 128 + 127 + W) >> 6) + 1; if (kt1 > (S >> 6)) kt1 = S >> 6;
  f32x16 O[1][4]; float linv[1];
  attn_core<64, 128, 1, 2, true, 0>(qkv + (size_t)(12 + head * 2 + map) * CHS + (size_t)qrow0 * 64, 64, qkv + (size_t)(20 + head * 2) * CHS + (size_t)seq_tok0 * 64, CHS,
                                    qkv + (size_t)(28 + head * 2) * CHS + seq_tok0, VTP, kt0, kt1, map, shift, slope, qpos0, smem, O, linv);
  const int tid2 = opaque_tid(), lane2 = tid2 & 63, c2 = tid2 & 31, h2 = (tid2 >> 5) & 1, map2 = (tid2 >> 6) & 1, qp2 = tid2 >> 7;
  const int t = seq_tok0 + qb * 128 + qp2 * 32 + c2;
  float* xch = (float*)smem + (size_t)qp2 * 4096;
  if (map2 == 1) {
#pragma unroll
    for (int d = 0; d < 4; ++d)
#pragma unroll
      for (int i = 0; i < 16; ++i) xch[(d * 16 + i) * 64 + lane2] = O[0][d][i] * linv[0];
  }
  __syncthreads();
  if (map2 == 0) {
    const float lamv = scal[3], omul = scal[4];
    float ss = 0.f;
#pragma unroll
    for (int d = 0; d < 4; ++d)
#pragma unroll
      for (int i = 0; i < 16; ++i) {
        const float o = O[0][d][i] * linv[0] - lamv * xch[(d * 16 + i) * 64 + lane2];
        O[0][d][i] = o; ss += o * o;
      }
    ss = half_sum(ss);
    const float rs = rsqrtf(ss * (1.f / 128.f) + EPS) * omul;
#pragma unroll
    for (int d = 0; d < 4; ++d)
#pragma unroll
      for (int g4 = 0; g4 < 4; ++g4) {
        const int dv = d * 32 + 8 * g4 + 4 * h2;
        const f32x4 gv = *(const f32x4*)(gsub + dv);
        u32x2 pk;
        pk.x = cvt_pk(O[0][d][4 * g4] * rs * gv.x, O[0][d][4 * g4 + 1] * rs * gv.y);
        pk.y = cvt_pk(O[0][d][4 * g4 + 2] * rs * gv.z, O[0][d][4 * g4 + 3] * rs * gv.w);
        st8(outp + (size_t)t * LDH + 512 + head * 128 + dv, pk);
      }
  }
  __syncthreads();
}

DI void attn_c_item(const bf16_t* qc, const bf16_t* memK, const bf16_t* memVt, bf16_t* co, int head, int gqb, float shift, char* smem) {
  const int tid_ = opaque_tid(), w = tid_ >> 6, lane = tid_ & 63, c = lane & 31, h = lane >> 5;
  const int tok0 = gqb * 256, qrow0 = tok0 + w * 32;
  const int ms = tok0 < TP ? (tok0 >> 13) : 2 + ((tok0 - TP) >> 12);
  f32x16 O[1][4]; float linv[1];
  attn_core<128, 128, 1, 1, false, 0>(qc + (size_t)qrow0 * 512 + head * 128, 512, memK + ((size_t)head * 1536 + ms * 256) * 128, 0,
                                   memVt + (size_t)head * 128 * 1536 + ms * 256, 1536, 0, 4, 0, shift, 0.f, 0, smem, O, linv);
  const int tid2 = opaque_tid(), c2 = tid2 & 31, h2 = (tid2 >> 5) & 1;
  const int t = tok0 + (tid2 >> 6) * 32 + c2;
#pragma unroll
  for (int d = 0; d < 4; ++d)
#pragma unroll
    for (int g4 = 0; g4 < 4; ++g4) {
      u32x2 pk;
      pk.x = cvt_pk(O[0][d][4 * g4] * linv[0], O[0][d][4 * g4 + 1] * linv[0]);
      pk.y = cvt_pk(O[0][d][4 * g4 + 2] * linv[0], O[0][d][4 * g4 + 3] * linv[0]);
      st8(co + (size_t)t * LDCO + head * 128 + d * 32 + 8 * g4 + 4 * h2, pk);
    }
}


#define XB_TMO      128
#define XB_XCNT(j)  (256  + 64 * (j))
#define XB_XSUB(j)  (1280 + 64 * (j))
#define XB_XGEN(j)  (2304 + 64 * (j))
#define XB_TOP      3328
#define XB_TOPGEN   3392
#define XCD_BAR_WORDS 3456
#define XB_SPIN_CAP (1u << 20)
#define LAS __attribute__((address_space(3)))
DI unsigned xb_ld(unsigned* p)              { return __hip_atomic_load(p, __ATOMIC_RELAXED, __HIP_MEMORY_SCOPE_AGENT); }
DI unsigned xb_add(unsigned* p, unsigned v) { return __hip_atomic_fetch_add(p, v, __ATOMIC_RELAXED, __HIP_MEMORY_SCOPE_AGENT); }
DI unsigned xb_xcc_id() { return (unsigned)__builtin_amdgcn_s_getreg((3 << 11) | 20) & 0xFu; }
#define XB_SPIN(cond, bar) do { unsigned _sp = 0; while (cond) { __builtin_amdgcn_s_sleep(1); \
    if ((++_sp & 255u) == 0u) { if (xb_ld(&(bar)[XB_TMO])) break; if (_sp > XB_SPIN_CAP) { atomicAdd(&(bar)[XB_TMO], 1u); break; } } } } while (0)
struct XcdBarrier { unsigned* bar; unsigned x; volatile LAS unsigned* st; };
DI XcdBarrier xcd_barrier_post(unsigned* bar, volatile LAS unsigned* st) {
  XcdBarrier b; b.bar = bar; b.x = xb_xcc_id(); b.st = st;
  if (threadIdx.x == 0) (void)xb_add(&bar[XB_XCNT(b.x)], 1u);
  return b;
}
DI void xcd_barrier_complete(unsigned* bar, unsigned x, unsigned& nloc, unsigned& nx) {
  const unsigned G = gridDim.x;
  unsigned sum, cnt, mine, sp = 0u;
  for (;;) {
    sum = 0u; cnt = 0u; mine = 0u;
#pragma unroll
    for (unsigned j = 0; j < 16; ++j) { const unsigned c = xb_ld(&bar[XB_XCNT(j)]); sum += c; cnt += (c > 0u) ? 1u : 0u; mine = (j == x) ? c : mine; }
    if (sum == G) break;
    __builtin_amdgcn_s_sleep(1);
    if ((++sp & 255u) == 0u) { if (xb_ld(&bar[XB_TMO])) break; if (sp > XB_SPIN_CAP) { atomicAdd(&bar[XB_TMO], 1u); break; } }
  }
  nloc = mine > 0u ? mine : 1u; nx = cnt > 0u ? cnt : 1u;
}
DI void xcd_barrier(const XcdBarrier& b) {
  asm volatile("s_waitcnt vmcnt(0)" ::: "memory");
  __syncthreads();
  if (threadIdx.x == 0) {
    unsigned* bar = b.bar;
    __builtin_amdgcn_s_waitcnt(0);
    unsigned nloc = b.st[0], nx = b.st[1];
    if (nloc == 0u) { xcd_barrier_complete(bar, b.x, nloc, nx); b.st[0] = nloc; b.st[1] = nx; }
    const unsigned old = xb_add(&bar[XB_XSUB(b.x)], 1u);
    const unsigned gen = old / nloc;
    if (old + 1u == (gen + 1u) * nloc) {
      __builtin_amdgcn_fence(__ATOMIC_RELEASE, "agent");
      asm volatile("s_waitcnt vmcnt(0)" ::: "memory");
      const unsigned og = xb_add(&bar[XB_TOP], 1u);
      const unsigned tg = og / nx;
      if (og + 1u == (tg + 1u) * nx) xb_add(&bar[XB_TOPGEN], 1u);
      else XB_SPIN(xb_ld(&bar[XB_TOPGEN]) == tg, bar);
      __builtin_amdgcn_fence(__ATOMIC_ACQUIRE, "agent");
      xb_add(&bar[XB_XGEN(b.x)], 1u);
      asm volatile("s_waitcnt vmcnt(0)" ::: "memory");
    } else {
      XB_SPIN(xb_ld(&bar[XB_XGEN(b.x)]) == gen, bar);
      __builtin_amdgcn_fence(__ATOMIC_ACQUIRE, "agent");
      asm volatile("s_waitcnt vmcnt(0)" ::: "memory");
    }
  }
  __syncthreads();
}

__global__ void __launch_bounds__(NTHR) fwd_kernel(Params p) {
  extern __shared__ __attribute__((aligned(16))) char smem[];
  int pidx = 0;
#define RUN_PHASE() (pidx >= p.ph0 && pidx < p.ph1)
#define END_PHASE() do { if (pidx >= p.ph0 && pidx + 1 < p.ph1) { if (pidx == 0) cg::this_grid().sync(); else xcd_barrier(xb); } ++pidx; } while (0)
  volatile LAS unsigned* xst = (volatile LAS unsigned*)(smem + SMEM_BYTES - 32);
  if (threadIdx.x == 0) { xst[0] = 0u; xst[1] = 0u; }
  __syncthreads();
  XcdBarrier xb = xcd_barrier_post((unsigned*)(p.ws + OFF_BAR), xst);
#define PHASE_ENV() char* ws = p.ws; bf16_t* hb = (bf16_t*)(ws + OFF_HB); bf16_t* memhb = (bf16_t*)(ws + OFF_MEMHB); f32x2* rope = (f32x2*)(ws + OFF_ROPE); \
  bf16_t* qkv = (bf16_t*)(ws + OFF_R); bf16_t* qc = (bf16_t*)(ws + OFF_R); bf16_t* act = (bf16_t*)(ws + OFF_R); char* wl = ws + (size_t)l * SZ_WLAYER; \
  bf16_t* xb = (bf16_t*)(ws + OFF_XB); float* ssp = (float*)(ws + OFF_SSP); \
  (void)hb; (void)memhb; (void)rope; (void)qkv; (void)qc; (void)act; (void)wl; (void)xb; (void)ssp;

  if (RUN_PHASE()) {
    int rot = 0;
#pragma unroll 1
    for (int l = 0; l < 2; ++l) {
      PHASE_ENV();
      convert_w(p.w_in + (size_t)l * 1024 * 2304, p.g_mix + l * 1024, (bf16_t*)(wl + OFF_WIN), 1024, 2304, 0, smem, rot);
      convert_w(p.w_out + (size_t)l * 1024 * 1024, nullptr, (bf16_t*)(wl + OFF_WOUT), 1024, 1024, 0, smem, rot);
      convert_w(p.wc_q + (size_t)l * 1024 * 512, p.g_cross + l * 1024, (bf16_t*)(wl + OFF_WCQ), 1024, 512, 0, smem, rot);
      convert_w(p.wc_kv + (size_t)l * 1024 * 1024, p.g_mem + l * 1024, (bf16_t*)(wl + OFF_WCKV), 1024, 1024, 0, smem, rot);
      convert_w(p.wc_o + (size_t)l * 512 * 1024, nullptr, (bf16_t*)(wl + OFF_WCO), 512, 1024, 0, smem, rot);
      convert_w(p.w_gu + (size_t)l * 1024 * 5632, p.g_ffn + l * 1024, (bf16_t*)(wl + OFF_WGU), 1024, 5632, 1, smem, rot);
      convert_w(p.w_dn + (size_t)l * 2816 * 1024, nullptr, (bf16_t*)(wl + OFF_WDN), 2816, 1024, 0, smem, rot);
    }
    if (blockIdx.x == 0 && threadIdx.x < 64) {
#pragma unroll 1
      for (int l = 0; l < 2; ++l) {
        PHASE_ENV();
        const int lane = opaque_tid() & 63;
        const float lam_init = l == 0 ? 0.2f : 0.35550906759096926f;
        const float sA = 8.f * gain_bound(p.ga_q + l * 64, 64) * gain_bound(p.ga_k + l * 64, 64) * LOG2E;
        const float sB = 8.f * gain_bound(p.gb_q + l * 64, 64) * gain_bound(p.gb_k + l * 64, 64) * LOG2E;
        const float sC = 11.313708498984761f * gain_bound(p.gc_q + l * 128, 128) * gain_bound(p.gc_k + l * 128, 128) * LOG2E;
        const float d1 = wave_sum(p.lq1[l * 64 + lane] * p.lk1[l * 64 + lane]), d2 = wave_sum(p.lq2[l * 64 + lane] * p.lk2[l * 64 + lane]);
        const float lam = expf(d1) - expf(d2) + lam_init;
        float* sc = (float*)(ws + OFF_SCAL) + l * 8;
        if (lane == 0) { sc[0] = sA; sc[1] = sB; sc[2] = sC; sc[3] = lam; sc[4] = 1.f - lam_init; ((unsigned*)(ws + OFF_SCAL + 128))[l] = 0u; }
      }
    }
    { const int l = 0; PHASE_ENV(); rope_table(rope); norm_rows(p.memp, p.mems, 512, 1536, memhb, nullptr); norm_rows(p.xp, p.xs, TP, T, xb, ssp); }
  }
  END_PHASE();

#pragma unroll 1
  for (int l = 0; l < 2; ++l) {
    if (RUN_PHASE()) {
      PHASE_ENV();
      EpiQKV e{qkv, p.ga_q + l * 64, p.ga_k + l * 64, p.gb_q + l * 64, p.gb_k + l * 64, rope, ssp};
      gemm_phase(xb, LDH, (const bf16_t*)(wl + OFF_WIN), 1024 + KPAD, T, 2304, 1024, smem, e);
      if (l == 0) {
#pragma unroll 1
        for (int l2 = 0; l2 < 2; ++l2) {
          EpiN128 ek{(bf16_t*)(ws + OFF_MEMK + l2 * SZ_MEMK), (size_t)1536 * 128, 128, p.gc_k + l2 * 128, 1.f, 512, (bf16_t*)(ws + OFF_MEMVT + l2 * SZ_MEMK), 1536, nullptr};
          gemm_phase(memhb, LDH, (const bf16_t*)(ws + (size_t)l2 * SZ_WLAYER + OFF_WCKV), 1024 + KPAD, 1536, 1024, 1024, smem, ek);
        }
      }
    }
    END_PHASE();
    if (RUN_PHASE()) {
      PHASE_ENV();
      const float* scal = (const float*)(ws + OFF_SCAL) + l * 8;
      unsigned* qctr = (unsigned*)(ws + OFF_SCAL + 128) + l;
      volatile int* qslot = (volatile int*)(smem + SMEM_BYTES - 16);
#pragma unroll 1
      for (;;) {
        __syncthreads();
        if (threadIdx.x == 0) *qslot = (int)atomicAdd(qctr, 1u);
        __syncthreads();
        const int it = __builtin_amdgcn_readfirstlane(*qslot);
        if (it >= 1536) break;
        int isB, seq_tok0, S, hk, qb;
        if (it < 256) { isB = 0; S = 8192; const int combo = it >> 6; seq_tok0 = (combo >> 1) * 8192; hk = combo & 1; qb = it & 63; }
        else if (it < 512) { const int j = it - 256; isB = 1; S = 8192; const int combo = j >> 6; seq_tok0 = (combo >> 1) * 8192; hk = 3 - (combo & 1); qb = j & 63; }
        else if (it < 768) { const int j = it - 512; isB = 0; S = 4096; const int combo = j >> 5; seq_tok0 = TP + (combo >> 1) * 4096; hk = combo & 1; qb = j & 31; }
        else if (it < 896) { const int j = it - 768; isB = 1; S = 8192; seq_tok0 = (j >> 6) * 8192; hk = 1; qb = j & 63; }
        else if (it < 1152) { const int j = it - 896; isB = 1; S = 4096; const int combo = j >> 5; seq_tok0 = TP + (combo >> 1) * 4096; hk = 3 - (combo & 1); qb = j & 31; }
        else if (it < 1280) { const int j = it - 1152; isB = 1; S = 4096; seq_tok0 = TP + (j >> 5) * 4096; hk = 1; qb = j & 31; }
        else if (it < 1408) { const int j = it - 1280; isB = 1; S = 8192; seq_tok0 = (j >> 6) * 8192; hk = 0; qb = j & 63; }
        else { const int j = it - 1408; isB = 1; S = 4096; seq_tok0 = TP + (j >> 5) * 4096; hk = 0; qb = j & 31; }
        if (isB) attn_b_item(qkv, hb, seq_tok0, S, hk, qb, scal, p.gb_sub + l * 128, smem);
        else attn_a_item(qkv, hb, seq_tok0, S, hk, qb, 0.f, smem);
      }
    }
    END_PHASE();
    if (RUN_PHASE()) {
      PHASE_ENV();
      EpiResid e{xb, ssp, nullptr};
      gemm_phase(hb, LDH, (const bf16_t*)(wl + OFF_WOUT), 1024 + KPAD, T, 1024, 1024, smem, e);
    }
    END_PHASE();
    if (RUN_PHASE()) {
      PHASE_ENV();
      EpiN128 e{qc, 128, 512, p.gc_q + l * 128, 0.08838834764831845f * LOG2E, 512, nullptr, 0, ssp};
      gemm_phase(xb, LDH, (const bf16_t*)(wl + OFF_WCQ), 1024 + KPAD, T, 512, 1024, smem, e);
    }
    END_PHASE();
    if (RUN_PHASE()) {
      PHASE_ENV();
#pragma unroll 1
      for (int it = blockIdx.x; it < 512; it += gridDim.x)
        attn_c_item(qc, (const bf16_t*)(ws + OFF_MEMK + l * SZ_MEMK), (const bf16_t*)(ws + OFF_MEMVT + l * SZ_MEMK), hb, it & 3, it >> 2, 0.f, smem);
    }
    END_PHASE();
    if (RUN_PHASE()) {
      PHASE_ENV();
      EpiResid e{xb, ssp, nullptr};
      gemm_phase(hb, LDCO, (const bf16_t*)(wl + OFF_WCO), 512 + KPAD, T, 1024, 512, smem, e);
    }
    END_PHASE();
    if (RUN_PHASE()) {
      PHASE_ENV();
      EpiSwiGLU e{act, ssp};
      gemm_phase(xb, LDH, (const bf16_t*)(wl + OFF_WGU), 1024 + KPAD, T, 5632, 1024, smem, e);
    }
    END_PHASE();
    if (RUN_PHASE()) {
      PHASE_ENV();
      EpiResid e{xb, ssp, l == 1 ? p.out : nullptr};
      gemm_phase(act, LDACT, (const bf16_t*)(wl + OFF_WDN), 2816 + KPAD, T, 1024, 2816, smem, e);
    }
    if (l == 0) END_PHASE();
  }
}


#ifndef DBG_STOP
#define DBG_STOP 0
#endif
#if DBG_STOP
__global__ void dump_kernel(const bf16_t* src, size_t n_src, float* out) {
  const size_t n = (size_t)T * 1024;
  for (size_t i = (size_t)blockIdx.x * blockDim.x + threadIdx.x; i < n; i += (size_t)gridDim.x * blockDim.x) {
    float acc = 0.f;
    for (size_t j = i; j < n_src; j += n) acc += __uint_as_float((unsigned)src[j] << 16);
    out[i] = acc;
  }
}
#endif
constexpr int N_PHASES = 17;
#ifndef MK_MULTI_LAUNCH
#define MK_MULTI_LAUNCH 0
#endif
extern "C" void kernel_launch(void* const* d_in, const int* in_sizes, int n_in, void* d_out, int out_size, void* d_ws, size_t ws_size, hipStream_t stream) {
  static int grid_blocks = 0;
  if (!grid_blocks) {
    int dev = 0, cus = 0, per_cu = 0;
    (void)hipGetDevice(&dev);
    (void)hipDeviceGetAttribute(&cus, hipDeviceAttributeMultiprocessorCount, dev);
    (void)hipFuncSetAttribute((const void*)fwd_kernel, hipFuncAttributeMaxDynamicSharedMemorySize, SMEM_BYTES);
    (void)hipOccupancyMaxActiveBlocksPerMultiprocessor(&per_cu, fwd_kernel, NTHR, SMEM_BYTES);
    if (per_cu > 1) per_cu = 1;
    grid_blocks = cus * per_cu;
    if (ws_size < WS_NEED) fprintf(stderr, "workspace too small: %zu < %zu\n", ws_size, WS_NEED);
  }
  Params p{};
  const float** f = (const float**)&p;
  for (int i = 0; i < 26; ++i) f[i] = (const float*)d_in[i];
  p.out = (float*)d_out; p.ws = (char*)d_ws;
#if MK_MULTI_LAUNCH
#if DBG_STOP
  for (int ph = 0; ph < DBG_STOP; ++ph) {
    p.ph0 = ph; p.ph1 = ph + 1;
    hipLaunchKernelGGL(fwd_kernel, dim3(grid_blocks), dim3(NTHR), SMEM_BYTES, stream, p);
  }
  hipLaunchKernelGGL(dump_kernel, dim3(2048), dim3(256), 0, stream, (const bf16_t*)((char*)d_ws + DBG_OFF), (size_t)DBG_N, (float*)d_out);
#else
  for (int ph = 0; ph < N_PHASES; ++ph) {
    p.ph0 = ph; p.ph1 = ph + 1;
    hipLaunchKernelGGL(fwd_kernel, dim3(grid_blocks), dim3(NTHR), SMEM_BYTES, stream, p);
  }
#endif
#else
  p.ph0 = 0; p.ph1 = N_PHASES;
  (void)hipMemsetAsync((char*)d_ws + OFF_BAR, 0, XCD_BAR_WORDS * 4, stream);
  void* args[] = {&p};
  hipError_t e = hipLaunchCooperativeKernel((void*)fwd_kernel, dim3(grid_blocks), dim3(NTHR), args, SMEM_BYTES, stream);
  if (e != hipSuccess) fprintf(stderr, "cooperative launch failed: %s (grid %d)\n", hipGetErrorString(e), grid_blocks);
#endif
}
```

```cpp
#include <hip/hip_runtime.h>
#include <hip/hip_cooperative_groups.h>
#include <cstdio>
#include <cstdint>
namespace cg = cooperative_groups;

#define DI __device__ __forceinline__
typedef unsigned short bf16_t;
typedef short bf16x8 __attribute__((ext_vector_type(8)));
typedef float f32x16 __attribute__((ext_vector_type(16)));
typedef float f32x4 __attribute__((ext_vector_type(4)));
typedef float f32x2 __attribute__((ext_vector_type(2)));
typedef unsigned u32x4 __attribute__((ext_vector_type(4)));
typedef unsigned u32x2 __attribute__((ext_vector_type(2)));

constexpr int T = 32768, TP = 16384;
constexpr float LOG2E = 1.4426950408889634f;
constexpr float EPS = 1e-6f;
constexpr int NTHR = 512;
constexpr int SMEM_BYTES = 135168 + 1024;

constexpr int VTP = T + 64;
constexpr size_t CHS = (size_t)64 * VTP;
constexpr int KPAD = 64, LDH = 1024 + KPAD, LDCO = 512 + KPAD, LDACT = 2816 + KPAD;
constexpr size_t SZ_WIN = 2304ull * (1024 + KPAD) * 2, SZ_WOUT = 1024ull * (1024 + KPAD) * 2, SZ_WCQ = 512ull * (1024 + KPAD) * 2, SZ_WCKV = 1024ull * (1024 + KPAD) * 2,
                 SZ_WCO = 1024ull * (512 + KPAD) * 2, SZ_WGU = 5632ull * (1024 + KPAD) * 2, SZ_WDN = 1024ull * (2816 + KPAD) * 2;
constexpr size_t OFF_WIN = 0, OFF_WOUT = OFF_WIN + SZ_WIN, OFF_WCQ = OFF_WOUT + SZ_WOUT, OFF_WCKV = OFF_WCQ + SZ_WCQ, OFF_WCO = OFF_WCKV + SZ_WCKV,
                 OFF_WGU = OFF_WCO + SZ_WCO, OFF_WDN = OFF_WGU + SZ_WGU, SZ_WLAYER = OFF_WDN + SZ_WDN;
constexpr size_t OFF_HB = 2 * SZ_WLAYER;
constexpr size_t OFF_MEMHB = OFF_HB + (size_t)T * LDH * 2;
constexpr size_t SZ_MEMK = 4ull * 1536 * 128 * 2;
constexpr size_t OFF_MEMK = OFF_MEMHB + 1536ull * LDH * 2;
constexpr size_t OFF_MEMVT = OFF_MEMK + 2 * SZ_MEMK;
constexpr size_t OFF_ROPE = OFF_MEMVT + 2 * SZ_MEMK;
constexpr size_t OFF_SCAL = OFF_ROPE + 128 * 16 * 8;
constexpr size_t OFF_BAR = OFF_SCAL + 256;
constexpr size_t OFF_R = OFF_BAR + 16384;
constexpr size_t OFF_XB = OFF_R + (size_t)T * LDACT * 2;
constexpr size_t OFF_SSP = OFF_XB + (size_t)T * LDH * 2;
constexpr size_t WS_NEED = OFF_SSP + (size_t)T * 16 * 4;

struct Params {
  const float* xp; const float* xs; const float* memp; const float* mems;
  const float* g_mix; const float* w_in; const float* ga_q; const float* ga_k; const float* gb_q; const float* gb_k;
  const float* lq1; const float* lk1; const float* lq2; const float* lk2; const float* gb_sub;
  const float* w_out; const float* g_cross; const float* g_mem; const float* wc_q; const float* wc_kv; const float* gc_q; const float* gc_k;
  const float* wc_o; const float* g_ffn; const float* w_gu; const float* w_dn;
  float* out; char* ws;
  int ph0; int ph1;
};

struct Params;
DI const Params* kargs() { unsigned long long kp = (unsigned long long)__builtin_amdgcn_kernarg_segment_ptr(); asm volatile("" : "+s"(kp)); return (const Params*)kp; }
DI int opaque_tid() {
  const int w = __builtin_amdgcn_readfirstlane((int)threadIdx.x >> 6);
  int t = (w << 6) | (int)__builtin_amdgcn_mbcnt_hi(~0u, __builtin_amdgcn_mbcnt_lo(~0u, 0u));
  asm volatile("" : "+v"(t)); return t; }
typedef __bf16 bf16x2_t __attribute__((ext_vector_type(2)));
DI unsigned cvt_pk(float lo, float hi) { f32x2 f = {lo, hi}; return __builtin_bit_cast(unsigned, __builtin_convertvector(f, bf16x2_t)); }
DI int crow(int i, int h) { return (i & 3) + 8 * (i >> 2) + 4 * h; }
template <int CTRL> DI float dppf(float v) { return __builtin_bit_cast(float, __builtin_amdgcn_update_dpp(0, __builtin_bit_cast(int, v), CTRL, 0xF, 0xF, true)); }
DI float rdlane(float v, int l) { return __builtin_bit_cast(float, __builtin_amdgcn_readlane(__builtin_bit_cast(int, v), l)); }
DI float wave_sum(float v) {
  v += dppf<0xB1>(v); v += dppf<0x4E>(v); v += dppf<0x141>(v); v += dppf<0x140>(v);
  return (rdlane(v, 0) + rdlane(v, 16)) + (rdlane(v, 32) + rdlane(v, 48));
}
DI float wave_max(float v) {
  v = fmaxf(v, dppf<0xB1>(v)); v = fmaxf(v, dppf<0x4E>(v)); v = fmaxf(v, dppf<0x141>(v)); v = fmaxf(v, dppf<0x140>(v));
  return fmaxf(fmaxf(rdlane(v, 0), rdlane(v, 16)), fmaxf(rdlane(v, 32), rdlane(v, 48)));
}
DI float half_sum(float x) {
  int idx = (int)((__builtin_amdgcn_mbcnt_hi(~0u, __builtin_amdgcn_mbcnt_lo(~0u, 0u)) ^ 32u) << 2);
  asm volatile("" : "+v"(idx));
  return x + __builtin_bit_cast(float, __builtin_amdgcn_ds_bpermute(idx, __builtin_bit_cast(int, x)));
}
DI int seqpos(int t) { return t < TP ? (t & 8191) : (t & 4095); }
DI f32x16 zero16() { f32x16 z; for (int i = 0; i < 16; ++i) z[i] = 0.f; return z; }
#define MFMA32(a, b, c) __builtin_amdgcn_mfma_f32_32x32x16_bf16((a), (b), (c), 0, 0, 0)

constexpr int GSTG = 32768;
constexpr int GEMM_XCH = 4 * GSTG;

DI void glds16(const void* g, char* l) { __builtin_amdgcn_global_load_lds((const unsigned*)g, (__attribute__((address_space(3))) unsigned*)l, 16, 0, 0); }
#define WAIT_VM0() asm volatile("s_waitcnt vmcnt(0)" ::: "memory")
#define WAIT_VMN(n) asm volatile("s_waitcnt vmcnt(" #n ") lgkmcnt(0)" ::: "memory")

template <class Epi>
DI void gemm_phase(const bf16_t* __restrict__ A, int lda, const bf16_t* __restrict__ Bt, int ldb, int M, int N, int K, char* smem, const Epi& epi) {
  const int tid = opaque_tid(), lane = tid & 63, w = tid >> 6;
  const int wm = w & 1, wn = w >> 1, r = lane & 31, h = lane >> 5;
  const int nN = N >> 8, nM = M >> 8, nk = K >> 5;
  const bool xcd = ((nM & 7) == 0) && ((gridDim.x & 7) == 0);
  const int first = xcd ? (int)(blockIdx.x >> 3) : (int)blockIdx.x, stride = xcd ? (int)(gridDim.x >> 3) : (int)gridDim.x, tot = xcd ? (nM >> 3) * nN : nM * nN;
  const int ntl = first < tot ? (tot - first + stride - 1) / stride : 0;
  if (ntl == 0) return;
#define TILE_MN(i, m0, n0) do { const int j_ = first + (i) * stride; const int q_ = j_ / nN; (n0) = (j_ - q_ * nN) << 8; (m0) = (xcd ? (int)(blockIdx.x & 7) + 8 * q_ : q_) << 8; } while (0)
  unsigned ga[2], gb[2];
#pragma unroll
  for (int i = 0; i < 2; ++i) {
    const int row = (w + 8 * i) * 16 + (lane >> 2), j = (lane & 3) ^ ((row >> 2) & 3);
    ga[i] = (unsigned)(row * lda + j * 8);
    gb[i] = (unsigned)(row * ldb + j * 8);
  }
  char* ldsw = smem + w * 1024 + lane * 16;
  const int sw = (r >> 2) & 3;
  const int a_off = (wm * 128 + r) * 64 + ((h ^ (sw & 1)) << 4);
  const int b_off = 16384 + (wn * 64 + r) * 64 + ((h ^ (sw & 1)) << 4);
  const int swz = (sw & 2) << 4;
  const int nk2 = nk >> 1, G = ntl * nk2;
  int it_i = 0, it_k = 0;
  const bf16_t* iA; const bf16_t* iB;
  { int m0, n0; TILE_MN(0, m0, n0); iA = A + (size_t)m0 * lda; iB = Bt + (size_t)n0 * ldb; }
#define ISSUE_PART(step, part) do { char* d_ = ldsw + ((step) & 1) * 2 * GSTG + ((part) >> 1) * GSTG + ((part) & 1) * 16384; \
    const bf16_t* s_ = (((part) & 1) ? iB : iA) + it_k * 64 + ((part) >> 1) * 32; const unsigned* o_ = ((part) & 1) ? gb : ga; \
    glds16(s_ + o_[0], d_); glds16(s_ + o_[1], d_ + 8192); } while (0)
#define ISSUE_ADV() do { if (++it_k == nk2) { it_k = 0; ++it_i; if (it_i < ntl) { int m0_, n0_; TILE_MN(it_i, m0_, n0_); iA = A + (size_t)m0_ * lda; iB = Bt + (size_t)n0_ * ldb; } } } while (0)
#define ISSUE(step) do { ISSUE_PART(step, 0); ISSUE_PART(step, 1); ISSUE_PART(step, 2); ISSUE_PART(step, 3); ISSUE_ADV(); } while (0)
#define LOADF(bf, af, rr) do { const char* s_ = sp + ((rr) >> 1) * GSTG + ((((rr) & 1) * 32) ^ swz); \
    _Pragma("unroll") for (int tn = 0; tn < 2; ++tn) bf[tn] = *(const bf16x8*)(s_ + b_off + tn * 2048); \
    _Pragma("unroll") for (int tm = 0; tm < 4; ++tm) af[tm] = *(const bf16x8*)(s_ + a_off + tm * 2048); } while (0)
#define MMAS(bf, af) do { \
    _Pragma("unroll") for (int tn = 0; tn < 2; ++tn) _Pragma("unroll") for (int tm = 0; tm < 4; ++tm) acc[tn][tm] = MFMA32(bf[tn], af[tm], acc[tn][tm]); \
    } while (0)
  __syncthreads();
  ISSUE(0);
  f32x16 acc[2][4];
#pragma unroll
  for (int a = 0; a < 2; ++a)
#pragma unroll
    for (int b = 0; b < 4; ++b) acc[a][b] = zero16();
  int ct_i = 0, ct_k = 0;
  if (__builtin_amdgcn_readfirstlane(w) >= 4) __builtin_amdgcn_s_setprio(1);
  const bool early = w < 4;
#pragma unroll 1
  for (int g = 0; g < G; ++g) {
    WAIT_VMN(0);
    __builtin_amdgcn_s_barrier();
    const bool more = g + 1 < G;
    const char* sp = smem + (g & 1) * 2 * GSTG;
    bf16x8 bf0[2], af0[4], bf1[2], af1[4];
    LOADF(bf0, af0, 0);
    LOADF(bf1, af1, 1);
    if (more) ISSUE_PART(g + 1, 0);
    MMAS(bf0, af0);
    LOADF(bf0, af0, 2);
    if (more) ISSUE_PART(g + 1, 1);
    MMAS(bf1, af1);
    LOADF(bf1, af1, 3);
    if (more) ISSUE_PART(g + 1, 2);
    MMAS(bf0, af0);
    if (more) { ISSUE_PART(g + 1, 3); ISSUE_ADV(); }
    MMAS(bf1, af1);
    if (++ct_k == nk2) {
      ct_k = 0;
      int m0, n0; TILE_MN(ct_i, m0, n0); ++ct_i;
      if (Epi::STAGED) __syncthreads();
      epi(acc, m0 + wm * 128, n0 + wn * 64, smem, smem + (g & 1) * 2 * GSTG + w * 8192);
#pragma unroll
      for (int a = 0; a < 2; ++a)
#pragma unroll
        for (int b = 0; b < 4; ++b) acc[a][b] = zero16();
    }
  }
  __builtin_amdgcn_s_setprio(0);
  WAIT_VMN(0);
  __syncthreads();
#undef LOADF
#undef MMAS
#undef ISSUE
#undef ISSUE_PART
#undef ISSUE_ADV
#undef TILE_MN
}

DI float row_rstd(const float* ssp, int t) {
  const f32x4* q = (const f32x4*)(ssp + (size_t)t * 16);
  const f32x4 a = q[0], b = q[1], c = q[2], d = q[3];
  const float s = ((a.x + a.y) + (a.z + a.w)) + ((b.x + b.y) + (b.z + b.w)) + ((c.x + c.y) + (c.z + c.w)) + ((d.x + d.y) + (d.z + d.w));
  return rsqrtf(s * (1.f / 1024.f) + EPS);
}
struct EpiQKV {
  static constexpr bool STAGED = false;
  bf16_t* qkv; const float* gaq; const float* gak; const float* gbq; const float* gbk; const f32x2* rope; const float* ssp;
  DI void operator()(f32x16 (&acc)[2][4], int mb, int nb, char*, char*) const {
    const int tid_ = opaque_tid(), lane = tid_ & 63, c = lane & 31, h = lane >> 5;
    const int chunk = nb >> 6;
    int kind; const float* g = gaq;
    if (chunk < 8) { kind = 0; g = gaq; } else if (chunk < 10) { kind = 1; g = gak; } else if (chunk < 12) { kind = 2; }
    else if (chunk < 20) { kind = 3; g = gbq; } else if (chunk < 28) { kind = 4; g = gbk; } else { kind = 2; }
    bf16_t* dst = qkv + (size_t)chunk * CHS;
    if (kind == 2) {
#pragma unroll
      for (int tm = 0; tm < 4; ++tm) {
        const int t = mb + tm * 32 + c;
        const float rstd = row_rstd(ssp, t);
#pragma unroll
        for (int tn = 0; tn < 2; ++tn)
#pragma unroll
          for (int i = 0; i < 16; i += 2) {
            const unsigned pk = cvt_pk(acc[tn][tm][i] * rstd, acc[tn][tm][i + 1] * rstd);
            dst[(size_t)(tn * 32 + crow(i, h)) * VTP + t] = (bf16_t)(pk & 0xffff);
            dst[(size_t)(tn * 32 + crow(i + 1, h)) * VTP + t] = (bf16_t)(pk >> 16);
          }
      }
      return;
    }
    const bool dorope = kind <= 1, isq = (kind == 0 || kind == 3);
    const float qmul = isq ? 0.125f * LOG2E : 1.f;
#pragma unroll
    for (int tm = 0; tm < 4; ++tm) {
      __builtin_amdgcn_sched_barrier(0);
      const int t = mb + tm * 32 + c;
      const float rstd = row_rstd(ssp, t);
      float ss = 0.f;
#pragma unroll
      for (int tn = 0; tn < 2; ++tn)
#pragma unroll
        for (int i = 0; i < 16; ++i) { acc[tn][tm][i] *= rstd; ss += acc[tn][tm][i] * acc[tn][tm][i]; }
      ss = half_sum(ss);
      const float rs = rsqrtf(ss * (1.f / 64.f) + EPS);
#pragma unroll
      for (int tn = 0; tn < 2; ++tn)
#pragma unroll
        for (int g4 = 0; g4 < 4; ++g4) {
          const f32x4 gv = *(const f32x4*)(g + tn * 32 + 8 * g4 + 4 * h);
          acc[tn][tm][4 * g4] *= rs * gv.x; acc[tn][tm][4 * g4 + 1] *= rs * gv.y; acc[tn][tm][4 * g4 + 2] *= rs * gv.z; acc[tn][tm][4 * g4 + 3] *= rs * gv.w;
        }
      if (dorope) {
        const int pos = seqpos(t);
#pragma unroll
        for (int tn = 0; tn < 2; ++tn) {
          __builtin_amdgcn_sched_barrier(0);
          const int pp = tn == 0 ? (pos >> 6) : (pos & 63);
#pragma unroll
          for (int i = 0; i < 8; ++i) {
            const int j = (i & 3) + 4 * h + 8 * (i >> 2);
            const f32x2 cs = rope[pp * 16 + j];
            const float x1 = acc[tn][tm][i], x2 = acc[tn][tm][i + 8];
            acc[tn][tm][i] = x1 * cs.x - x2 * cs.y;
            acc[tn][tm][i + 8] = x2 * cs.x + x1 * cs.y;
          }
        }
      }
#pragma unroll
      for (int tn = 0; tn < 2; ++tn)
#pragma unroll
        for (int g4 = 0; g4 < 4; ++g4) {
          u32x2 pk;
          pk.x = cvt_pk(acc[tn][tm][4 * g4] * qmul, acc[tn][tm][4 * g4 + 1] * qmul);
          pk.y = cvt_pk(acc[tn][tm][4 * g4 + 2] * qmul, acc[tn][tm][4 * g4 + 3] * qmul);
          *(u32x2*)(dst + (size_t)t * 64 + tn * 32 + 8 * g4 + 4 * h) = pk;
        }
    }
  }
};

struct EpiResid {
  static constexpr bool STAGED = true;
  bf16_t* xb; float* ssp; float* out;
  DI void operator()(f32x16 (&acc)[2][4], int mb, int nb, char*, char* stg) const {
    const int tid_ = opaque_tid(), lane = tid_ & 63, c = lane & 31, h = lane >> 5;
    const int rsub = lane >> 4, ch = lane & 15;
#pragma unroll
    for (int tm = 0; tm < 4; ++tm) {
#pragma unroll
      for (int tn = 0; tn < 2; ++tn)
#pragma unroll
        for (int g4 = 0; g4 < 4; ++g4) {
          const int k = tn * 8 + 2 * g4 + h;
          f32x4 v; v.x = acc[tn][tm][4 * g4]; v.y = acc[tn][tm][4 * g4 + 1]; v.z = acc[tn][tm][4 * g4 + 2]; v.w = acc[tn][tm][4 * g4 + 3];
          *(f32x4*)(stg + c * 256 + ((k ^ (c & 15)) << 4)) = v;
        }
#pragma unroll
      for (int kk = 0; kk < 8; ++kk) {
        const int rr = 4 * kk + rsub;
        const f32x4 v = *(const f32x4*)(stg + rr * 256 + ((ch ^ (rr & 15)) << 4));
        const int t = mb + tm * 32 + rr, n = nb + ch * 4;
        bf16_t* xp_ = xb + (size_t)t * LDH + n;
        const u32x2 xr = *(const u32x2*)xp_;
        f32x4 rv;
        rv.x = __uint_as_float(xr.x << 16) + v.x; rv.y = __uint_as_float(xr.x & 0xffff0000u) + v.y;
        rv.z = __uint_as_float(xr.y << 16) + v.z; rv.w = __uint_as_float(xr.y & 0xffff0000u) + v.w;
        u32x2 pk; pk.x = cvt_pk(rv.x, rv.y); pk.y = cvt_pk(rv.z, rv.w);
        *(u32x2*)xp_ = pk;
        if (out) *(f32x4*)(out + (size_t)t * 1024 + n) = rv;
        float ss = (rv.x * rv.x + rv.y * rv.y) + (rv.z * rv.z + rv.w * rv.w);
        ss += dppf<0xB1>(ss); ss += dppf<0x4E>(ss); ss += dppf<0x141>(ss); ss += dppf<0x140>(ss);
        if (ch == 0) ssp[(size_t)t * 16 + (nb >> 6)] = ss;
      }
    }
  }
};

struct EpiN128 {
  static constexpr bool STAGED = false;
  bf16_t* dstK; size_t kHeadStride; int kRowStride; const float* gain; float mul; int nsplit; bf16_t* dstVt; int vtld; const float* ssp;
  DI void operator()(f32x16 (&acc)[2][4], int mb, int nb, char* smem, char*) const {
    const int tid_ = opaque_tid(), lane = tid_ & 63, c = lane & 31, h = lane >> 5, w = tid_ >> 6;
    float* xch = (float*)(smem + GEMM_XCH);
    if (nb >= nsplit) {
      const int nv = nb - nsplit;
#pragma unroll
      for (int tm = 0; tm < 4; ++tm) {
        const int t = mb + tm * 32 + c;
#pragma unroll
        for (int tn = 0; tn < 2; ++tn)
#pragma unroll
          for (int i = 0; i < 16; i += 2) {
            const unsigned pk = cvt_pk(acc[tn][tm][i], acc[tn][tm][i + 1]);
            dstVt[(size_t)(nv + tn * 32 + crow(i, h)) * vtld + t] = (bf16_t)(pk & 0xffff);
            dstVt[(size_t)(nv + tn * 32 + crow(i + 1, h)) * vtld + t] = (bf16_t)(pk >> 16);
          }
      }
      return;
    }
    float ssv[4];
#pragma unroll
    for (int tm = 0; tm < 4; ++tm) {
      if (ssp) { const float rstd = row_rstd(ssp, mb + tm * 32 + c);
#pragma unroll
        for (int tn = 0; tn < 2; ++tn)
#pragma unroll
          for (int i = 0; i < 16; ++i) acc[tn][tm][i] *= rstd; }
      float ss = 0.f;
#pragma unroll
      for (int tn = 0; tn < 2; ++tn)
#pragma unroll
        for (int i = 0; i < 16; ++i) ss += acc[tn][tm][i] * acc[tn][tm][i];
      ss = half_sum(ss);
      ssv[tm] = ss;
      if (h == 0) xch[w * 128 + tm * 32 + c] = ss;
    }
    __syncthreads();
    const int head = nb >> 7, nin = nb & 127;
    bf16_t* dk = dstK + (size_t)head * kHeadStride;
#pragma unroll
    for (int tm = 0; tm < 4; ++tm) {
      const int t = mb + tm * 32 + c;
      const float ss = ssv[tm] + xch[(w ^ 2) * 128 + tm * 32 + c];
      const float rs = rsqrtf(ss * (1.f / 128.f) + EPS) * mul;
#pragma unroll
      for (int tn = 0; tn < 2; ++tn)
#pragma unroll
        for (int g4 = 0; g4 < 4; ++g4) {
          const int n = nin + tn * 32 + 8 * g4 + 4 * h;
          const f32x4 gv = *(const f32x4*)(gain + n);
          u32x2 pk;
          pk.x = cvt_pk(acc[tn][tm][4 * g4] * rs * gv.x, acc[tn][tm][4 * g4 + 1] * rs * gv.y);
          pk.y = cvt_pk(acc[tn][tm][4 * g4 + 2] * rs * gv.z, acc[tn][tm][4 * g4 + 3] * rs * gv.w);
          *(u32x2*)(dk + (size_t)t * kRowStride + n) = pk;
        }
    }
    __syncthreads();
  }
};

struct EpiSwiGLU {
  static constexpr bool STAGED = false;
  bf16_t* act; const float* ssp;
  DI void operator()(f32x16 (&acc)[2][4], int mb, int nb, char*, char*) const {
    const int tid_ = opaque_tid(), lane = tid_ & 63, c = lane & 31, h = lane >> 5;
    const int jb = (nb >> 6) * 32;
    int xidx = (lane ^ 32) << 2;
#pragma unroll
    for (int tm = 0; tm < 4; ++tm) {
      const int t = mb + tm * 32 + c;
      const float rstd = row_rstd(ssp, t);
      u32x2 pk[4];
#pragma unroll
      for (int g4 = 0; g4 < 4; ++g4) {
        float o[4];
#pragma unroll
        for (int e = 0; e < 4; ++e) {
          const float gt = acc[0][tm][4 * g4 + e] * rstd, up = acc[1][tm][4 * g4 + e] * rstd;
          o[e] = gt * __builtin_amdgcn_rcpf(1.f + __builtin_amdgcn_exp2f(-gt * LOG2E)) * up;
        }
        pk[g4].x = cvt_pk(o[0], o[1]); pk[g4].y = cvt_pk(o[2], o[3]);
      }
#pragma unroll
      for (int q = 0; q < 2; ++q) {
        const u32x2 mine = h ? pk[2 * q + 1] : pk[2 * q];
        const u32x2 give = h ? pk[2 * q] : pk[2 * q + 1];
        u32x2 got;
        got.x = (unsigned)__builtin_amdgcn_ds_bpermute(xidx, (int)give.x);
        got.y = (unsigned)__builtin_amdgcn_ds_bpermute(xidx, (int)give.y);
        u32x4 v;
        if (h) { v.x = got.x; v.y = got.y; v.z = mine.x; v.w = mine.y; } else { v.x = mine.x; v.y = mine.y; v.z = got.x; v.w = got.y; }
        *(u32x4*)(act + (size_t)t * LDACT + jb + 8 * (2 * q + h)) = v;
      }
    }
  }
};

DI void norm_rows(const float* src0, const float* src1, int split, int nrows, bf16_t* dst, float* ssp) {
  const int tid_ = opaque_tid(), lane = tid_ & 63, w = tid_ >> 6;
  for (int row = blockIdx.x * 8 + w; row < nrows; row += gridDim.x * 8) {
    const float* p = row < split ? src0 + (size_t)row * 1024 : src1 + (size_t)(row - split) * 1024;
    f32x4 v[4];
#pragma unroll
    for (int i = 0; i < 4; ++i) v[i] = *(const f32x4*)(p + i * 256 + lane * 4);
    float ss = 0.f;
#pragma unroll
    for (int i = 0; i < 4; ++i) ss += v[i].x * v[i].x + v[i].y * v[i].y + v[i].z * v[i].z + v[i].w * v[i].w;
    ss = wave_sum(ss);
    const float rs = ssp ? 1.f : rsqrtf(ss * (1.f / 1024.f) + EPS);
    if (ssp && lane < 16) ssp[(size_t)row * 16 + lane] = lane == 0 ? ss : 0.f;
#pragma unroll
    for (int i = 0; i < 4; ++i) {
      u32x2 pk; pk.x = cvt_pk(v[i].x * rs, v[i].y * rs); pk.y = cvt_pk(v[i].z * rs, v[i].w * rs);
      *(u32x2*)(dst + (size_t)row * LDH + i * 256 + lane * 4) = pk;
    }
  }
}

DI void convert_w(const float* __restrict__ W, const float* __restrict__ g, bf16_t* __restrict__ Wt, int K, int N, int mode, char* smem, int& rot) {
  float* s = (float*)smem;
  const int tid = opaque_tid();
  const int nkt = K >> 6, nnt = N >> 6, nt = nkt * nnt;
  int start = (int)blockIdx.x - rot; if (start < 0) start += gridDim.x;
  for (int tile = start; tile < nt; tile += gridDim.x) {
    const int k0 = (tile / nnt) << 6, n0 = (tile % nnt) << 6;
    {
      const int row = tid >> 3, col = (tid & 7) * 8;
      const float gg = g ? g[k0 + row] : 1.f;
      const f32x4 a = *(const f32x4*)(W + (size_t)(k0 + row) * N + n0 + col);
      const f32x4 b = *(const f32x4*)(W + (size_t)(k0 + row) * N + n0 + col + 4);
      float* d = s + row * 65 + col;
      d[0] = a.x * gg; d[1] = a.y * gg; d[2] = a.z * gg; d[3] = a.w * gg; d[4] = b.x * gg; d[5] = b.y * gg; d[6] = b.z * gg; d[7] = b.w * gg;
    }
    __syncthreads();
    {
      const int n = tid >> 3, kc = (tid & 7) * 8;
      int nn = n0 + n;
      if (mode == 1) { if (nn < 2816) nn = (nn >> 5) * 64 + (nn & 31); else { const int j = nn - 2816; nn = (j >> 5) * 64 + 32 + (j & 31); } }
      u32x4 pk;
      pk.x = cvt_pk(s[(kc + 0) * 65 + n], s[(kc + 1) * 65 + n]); pk.y = cvt_pk(s[(kc + 2) * 65 + n], s[(kc + 3) * 65 + n]);
      pk.z = cvt_pk(s[(kc + 4) * 65 + n], s[(kc + 5) * 65 + n]); pk.w = cvt_pk(s[(kc + 6) * 65 + n], s[(kc + 7) * 65 + n]);
      *(u32x4*)(Wt + (size_t)nn * (K + KPAD) + k0 + kc) = pk;
    }
    __syncthreads();
  }
  rot = (rot + nt) % (int)gridDim.x;
}

__device__ const double kInvFreq[16] = {1.0, 0.5623413251903491, 0.31622776601683794, 0.1778279410038923, 0.1, 0.05623413251903491, 0.031622776601683794,
                                        0.01778279410038923, 0.01, 0.005623413251903491, 0.0031622776601683794, 0.001778279410038923, 0.001,
                                        0.0005623413251903491, 0.00031622776601683794, 0.0001778279410038923};
DI void rope_table(f32x2* tab) {
  const int idx = blockIdx.x * NTHR + threadIdx.x;
  if (idx < 2048) {
    const int pidx = idx >> 4, j = idx & 15;
    const double th = (double)pidx * kInvFreq[j];
    const double twopi = 6.283185307179586476925;
    const double kk = rint(th / twopi);
    const double r = th - kk * twopi, r2 = r * r;
    double ts = r, tc = 1.0, sn = r, cs = 1.0;
    for (int n = 1; n <= 15; ++n) { tc *= -r2 / (double)((2 * n - 1) * (2 * n)); cs += tc; ts *= -r2 / (double)((2 * n) * (2 * n + 1)); sn += ts; }
    f32x2 o; o.x = (float)cs; o.y = (float)sn; tab[idx] = o;
  }
}

template <int D, int DV, int QT, int NK, bool ALIBI, int QL>
DI void attn_core(const bf16_t* __restrict__ qbase, int qstride, const bf16_t* __restrict__ kbase, size_t kmapstride, const bf16_t* __restrict__ vtbase, size_t vtstride,
                  int kt0, int kt1, int kmap, float shift, float slope, int qpos0, char* smem, f32x16 (&O)[QT][DV / 32], float (&linv)[QT]) {
  constexpr int KROW = D * 2, KBYTES = NK * 64 * KROW, VBYTES = DV * 128, STAGE = KBYTES + VBYTES;
  constexpr int NKI = KBYTES / 8192, NVI = VBYTES / 8192;
  const int tid = opaque_tid(), lane = tid & 63, w = tid >> 6;
  const int c = lane & 31, h = lane >> 5;
  bf16x8 qf[QT - QL > 0 ? QT - QL : 1][D / 16];
  char* qlds = smem + 2 * STAGE + w * (QL * (D / 16) * 1024) + lane * 16;
  __syncthreads();
#pragma unroll
  for (int qt = 0; qt < QT; ++qt)
#pragma unroll
    for (int ks = 0; ks < D / 16; ++ks) {
      const bf16x8 q = *(const bf16x8*)(qbase + (size_t)(qt * 32 + c) * qstride + ks * 16 + 8 * h);
      if (qt < QT - QL) qf[qt][ks] = q; else *(bf16x8*)(qlds + ((qt - (QT - QL)) * (D / 16) + ks) * 1024) = q;
    }
#pragma unroll
  for (int qt = 0; qt < QT; ++qt) {
    linv[qt] = 0.f;
#pragma unroll
    for (int d = 0; d < DV / 32; ++d) O[qt][d] = zero16();
  }
  unsigned ksrc[NKI], vsrc[NVI];
#pragma unroll
  for (int i = 0; i < NKI; ++i) {
    const int blk = w + 8 * i;
    if (D == 64) {
      const int row = blk * 8 + (lane >> 3), j = (lane & 7) ^ ((row >> 1) & 7);
      ksrc[i] = (unsigned)((row >> 6) * (int)kmapstride + (row & 63) * 64 + j * 8);
    } else {
      const int row = blk * 4 + (lane >> 4), j = (lane & 15) ^ (row & 15);
      ksrc[i] = (unsigned)(row * 128 + j * 8);
    }
  }
#pragma unroll
  for (int i = 0; i < NVI; ++i) {
    const int row = (w + 8 * i) * 8 + (lane >> 3), j = (lane & 7) ^ ((row >> 1) & 7);
    vsrc[i] = (unsigned)(row * (int)vtstride + j * 8);
  }
  char* ldsw = smem + w * 1024 + lane * 16;
  WAIT_VM0();
  __syncthreads();
#pragma unroll
  for (int i = 0; i < NKI; ++i) glds16(kbase + (size_t)kt0 * 64 * D + ksrc[i], ldsw + (kt0 & 1) * STAGE + i * 8192);
#pragma unroll
  for (int i = 0; i < NVI; ++i) glds16(vtbase + kt0 * 64 + vsrc[i], ldsw + (kt0 & 1) * STAGE + KBYTES + i * 8192);
  WAIT_VM0();
  __syncthreads();
  const int pr = (c & 0x13) | ((c & 4) << 1) | ((c & 8) >> 1);
  int koff, kswz;
  if (D == 64) { const int sw = (pr >> 1) & 7; koff = (kmap * 64 + pr) * KROW + ((h ^ (sw & 1)) << 4); kswz = (sw & 6) << 4; }
  else { const int sw = pr & 15; koff = pr * KROW + ((h ^ (sw & 1)) << 4); kswz = (sw & 14) << 4; }
  const int vsw = (c >> 1) & 7;
  const int voff = KBYTES + c * 128 + ((h ^ (vsw & 1)) << 4), vswz = (vsw & 6) << 4;
  const float nshift = -shift;
  const float lanebase = (float)(8 * h - qpos0 - c);
  if (__builtin_amdgcn_readfirstlane(w) >= 4) __builtin_amdgcn_s_setprio(1);
#pragma unroll 1
  for (int kt = kt0; kt < kt1; ++kt) {
    const char* sb = smem + (kt & 1) * STAGE;
#pragma unroll
    for (int kk = 0; kk < 2; ++kk) {
      bf16x8 pf[QT][2];
      {
        f32x16 S[QT];
#pragma unroll
        for (int qt = 0; qt < QT; ++qt) {
          if (ALIBI) {
            const float dbase = lanebase + (float)(kt * 64 + kk * 32 - qt * 32);
            const int kb_ = kt * 64 + kk * 32, qb_ = qpos0 + qt * 32;
            if (kb_ >= qb_ + 31 || kb_ + 31 <= qb_) {
              const float sl = kb_ >= qb_ + 31 ? -slope : slope;
              const float b0 = __builtin_fmaf(sl, dbase, nshift);
#pragma unroll
              for (int i = 0; i < 16; ++i) S[qt][i] = __builtin_fmaf(sl, (float)(16 * (i >> 3) + (i & 7)), b0);
            } else {
#pragma unroll
              for (int i = 0; i < 16; ++i) S[qt][i] = __builtin_fmaf(-slope, __builtin_fabsf(dbase + (float)(16 * (i >> 3) + (i & 7))), nshift);
            }
          } else {
            S[qt] = zero16();
          }
        }
#pragma unroll
        for (int ks = 0; ks < D / 16; ++ks) {
          const bf16x8 kf = *(const bf16x8*)(sb + koff + kk * 32 * KROW + ((ks * 32) ^ kswz));
#pragma unroll
          for (int qt = 0; qt < QT; ++qt) {
            if (qt < QT - QL) S[qt] = MFMA32(kf, qf[qt][ks], S[qt]);
            else S[qt] = MFMA32(kf, *(const bf16x8*)(qlds + ((qt - (QT - QL)) * (D / 16) + ks) * 1024), S[qt]);
          }
        }
#pragma unroll
        for (int qt = 0; qt < QT; ++qt)
#pragma unroll
          for (int s = 0; s < 2; ++s) {
            float e[8];
#pragma unroll
            for (int j = 0; j < 8; ++j) { e[j] = __builtin_amdgcn_exp2f(S[qt][8 * s + j]); linv[qt] += e[j]; }
            u32x4 pk; pk.x = cvt_pk(e[0], e[1]); pk.y = cvt_pk(e[2], e[3]); pk.z = cvt_pk(e[4], e[5]); pk.w = cvt_pk(e[6], e[7]);
            pf[qt][s] = __builtin_bit_cast(bf16x8, pk);
          }
      }
#pragma unroll
      for (int d = 0; d < DV / 32; ++d)
#pragma unroll
        for (int s = 0; s < 2; ++s) {
          const bf16x8 vf = *(const bf16x8*)(sb + voff + d * 4096 + (((kk * 4 + s * 2) * 16) ^ vswz));
#pragma unroll
          for (int qt = 0; qt < QT; ++qt) O[qt][d] = MFMA32(vf, pf[qt][s], O[qt][d]);
        }
      if (kk == 0) {
      if (kt + 1 < kt1) {
        char* d = ldsw + ((kt + 1) & 1) * STAGE;
        const bf16_t* kb2 = kbase + (size_t)(kt + 1) * 64 * D; const bf16_t* vb2 = vtbase + (kt + 1) * 64;
#pragma unroll
        for (int i = 0; i < NKI; ++i) glds16(kb2 + ksrc[i], d + i * 8192);
#pragma unroll
        for (int i = 0; i < NVI; ++i) glds16(vb2 + vsrc[i], d + KBYTES + i * 8192);
      }
      }
    }
    WAIT_VM0();
    __syncthreads();
  }
  __builtin_amdgcn_s_setprio(0);
#pragma unroll
  for (int qt = 0; qt < QT; ++qt) { float l = linv[qt]; l = half_sum(l); linv[qt] = 1.f / l; }
}

DI float gain_bound(const float* g, int n) {
  const int lane = opaque_tid() & 63;
  float m = fabsf(g[lane]);
  if (n > 64) m = fmaxf(m, fabsf(g[64 + lane]));
  return wave_max(m);
}

DI void attn_a_item(const bf16_t* qkv, bf16_t* outp, int seq_tok0, int S, int kvh, int qb, float shift, char* smem) {
  const int tid_ = opaque_tid(), w = tid_ >> 6, lane = tid_ & 63, c = lane & 31, h = lane >> 5;
  const int hd = kvh * 4 + (w & 3), qrow0 = seq_tok0 + qb * 128 + (w >> 2) * 64;
  f32x16 O[2][2]; float linv[2];
  attn_core<64, 64, 2, 1, false, 0>(qkv + (size_t)hd * CHS + (size_t)qrow0 * 64, 64, qkv + (size_t)(8 + kvh) * CHS + (size_t)seq_tok0 * 64, 0,
                                 qkv + (size_t)(10 + kvh) * CHS + seq_tok0, VTP, 0, S >> 6, 0, shift, 0.f, 0, smem, O, linv);
  const int tid2 = opaque_tid(), w2 = tid2 >> 6, c2 = tid2 & 31, h2 = (tid2 >> 5) & 1;
  const int hd2 = kvh * 4 + (w2 & 3), qrow2 = seq_tok0 + qb * 128 + (w2 >> 2) * 64;
#pragma unroll
  for (int qt = 0; qt < 2; ++qt) {
    const int t = qrow2 + qt * 32 + c2;
#pragma unroll
    for (int d = 0; d < 2; ++d)
#pragma unroll
      for (int g4 = 0; g4 < 4; ++g4) {
        u32x2 pk;
        pk.x = cvt_pk(O[qt][d][4 * g4] * linv[qt], O[qt][d][4 * g4 + 1] * linv[qt]);
        pk.y = cvt_pk(O[qt][d][4 * g4 + 2] * linv[qt], O[qt][d][4 * g4 + 3] * linv[qt]);
        *(u32x2*)(outp + (size_t)t * LDH + hd2 * 64 + d * 32 + 8 * g4 + 4 * h2) = pk;
      }
  }
}

DI void attn_b_item(const bf16_t* qkv, bf16_t* outp, int seq_tok0, int S, int head, int qb, const float* scal, const float* gsub, char* smem) {
  const int tid_ = opaque_tid(), w = tid_ >> 6;
  const int map = w & 1, qp = w >> 1, qpos0 = qb * 128 + qp * 32, qrow0 = seq_tok0 + qpos0;
  const float slope = exp2f(-2.f * (float)(head + 1)) * LOG2E;
  const float shift = scal[1];
  const float wf = fminf((150.f + 2.f * shift) / slope + 1.f, 65536.f);
  const int W = __builtin_amdgcn_readfirstlane((int)wf);
  int kt0 = (qb * 128 - W) >> 6; if (kt0 < 0) kt0 = 0;
  int kt1 = ((qb * 128 + 127 + W) >> 6) + 1; if (kt1 > (S >> 6)) kt1 = S >> 6;
  f32x16 O[1][4]; float linv[1];
  attn_core<64, 128, 1, 2, true, 0>(qkv + (size_t)(12 + head * 2 + map) * CHS + (size_t)qrow0 * 64, 64, qkv + (size_t)(20 + head * 2) * CHS + (size_t)seq_tok0 * 64, CHS,
                                    qkv + (size_t)(28 + head * 2) * CHS + seq_tok0, VTP, kt0, kt1, map, shift, slope, qpos0, smem, O, linv);
  const int tid2 = opaque_tid(), lane2 = tid2 & 63, c2 = tid2 & 31, h2 = (tid2 >> 5) & 1, map2 = (tid2 >> 6) & 1, qp2 = tid2 >> 7;
  const int t = seq_tok0 + qb * 128 + qp2 * 32 + c2;
  float* xch = (float*)smem + (size_t)qp2 * 4096;
  if (map2 == 1) {
#pragma unroll
    for (int d = 0; d < 4; ++d)
#pragma unroll
      for (int i = 0; i < 16; ++i) xch[(d * 16 + i) * 64 + lane2] = O[0][d][i] * linv[0];
  }
  __syncthreads();
  if (map2 == 0) {
    const float lamv = scal[3], omul = scal[4];
    float ss = 0.f;
#pragma unroll
    for (int d = 0; d < 4; ++d)
#pragma unroll
      for (int i = 0; i < 16; ++i) {
        const float o = O[0][d][i] * linv[0] - lamv * xch[(d * 16 + i) * 64 + lane2];
        O[0][d][i] = o; ss += o * o;
      }
    ss = half_sum(ss);
    const float rs = rsqrtf(ss * (1.f / 128.f) + EPS) * omul;
#pragma unroll
    for (int d = 0; d < 4; ++d)
#pragma unroll
      for (int g4 = 0; g4 < 4; ++g4) {
        const int dv = d * 32 + 8 * g4 + 4 * h2;
        const f32x4 gv = *(const f32x4*)(gsub + dv);
        u32x2 pk;
        pk.x = cvt_pk(O[0][d][4 * g4] * rs * gv.x, O[0][d][4 * g4 + 1] * rs * gv.y);
        pk.y = cvt_pk(O[0][d][4 * g4 + 2] * rs * gv.z, O[0][d][4 * g4 + 3] * rs * gv.w);
        *(u32x2*)(outp + (size_t)t * LDH + 512 + head * 128 + dv) = pk;
      }
  }
  __syncthreads();
}

DI void attn_c_item(const bf16_t* qc, const bf16_t* memK, const bf16_t* memVt, bf16_t* co, int head, int gqb, float shift, char* smem) {
  const int tid_ = opaque_tid(), w = tid_ >> 6, lane = tid_ & 63, c = lane & 31, h = lane >> 5;
  const int tok0 = gqb * 256, qrow0 = tok0 + w * 32;
  const int ms = tok0 < TP ? (tok0 >> 13) : 2 + ((tok0 - TP) >> 12);
  f32x16 O[1][4]; float linv[1];
  attn_core<128, 128, 1, 1, false, 0>(qc + (size_t)qrow0 * 512 + head * 128, 512, memK + ((size_t)head * 1536 + ms * 256) * 128, 0,
                                   memVt + (size_t)head * 128 * 1536 + ms * 256, 1536, 0, 4, 0, shift, 0.f, 0, smem, O, linv);
  const int tid2 = opaque_tid(), c2 = tid2 & 31, h2 = (tid2 >> 5) & 1;
  const int t = tok0 + (tid2 >> 6) * 32 + c2;
#pragma unroll
  for (int d = 0; d < 4; ++d)
#pragma unroll
    for (int g4 = 0; g4 < 4; ++g4) {
      u32x2 pk;
      pk.x = cvt_pk(O[0][d][4 * g4] * linv[0], O[0][d][4 * g4 + 1] * linv[0]);
      pk.y = cvt_pk(O[0][d][4 * g4 + 2] * linv[0], O[0][d][4 * g4 + 3] * linv[0]);
      *(u32x2*)(co + (size_t)t * LDCO + head * 128 + d * 32 + 8 * g4 + 4 * h2) = pk;
    }
}


#define XB_TMO      128
#define XB_XCNT(j)  (256  + 64 * (j))
#define XB_XSUB(j)  (1280 + 64 * (j))
#define XB_XGEN(j)  (2304 + 64 * (j))
#define XB_TOP      3328
#define XB_TOPGEN   3392
#define XCD_BAR_WORDS 3456
#define XB_SPIN_CAP (1u << 20)
#define LAS __attribute__((address_space(3)))
DI unsigned xb_ld(unsigned* p)              { return __hip_atomic_load(p, __ATOMIC_RELAXED, __HIP_MEMORY_SCOPE_AGENT); }
DI unsigned xb_add(unsigned* p, unsigned v) { return __hip_atomic_fetch_add(p, v, __ATOMIC_RELAXED, __HIP_MEMORY_SCOPE_AGENT); }
DI unsigned xb_xcc_id() { return (unsigned)__builtin_amdgcn_s_getreg((3 << 11) | 20) & 0xFu; }
#define XB_SPIN(cond, bar) do { unsigned _sp = 0; while (cond) { __builtin_amdgcn_s_sleep(1); \
    if ((++_sp & 255u) == 0u) { if (xb_ld(&(bar)[XB_TMO])) break; if (_sp > XB_SPIN_CAP) { atomicAdd(&(bar)[XB_TMO], 1u); break; } } } } while (0)
struct XcdBarrier { unsigned* bar; unsigned x; volatile LAS unsigned* st; };
DI XcdBarrier xcd_barrier_post(unsigned* bar, volatile LAS unsigned* st) {
  XcdBarrier b; b.bar = bar; b.x = xb_xcc_id(); b.st = st;
  if (threadIdx.x == 0) (void)xb_add(&bar[XB_XCNT(b.x)], 1u);
  return b;
}
DI void xcd_barrier_complete(unsigned* bar, unsigned x, unsigned& nloc, unsigned& nx) {
  const unsigned G = gridDim.x;
  unsigned sum, cnt, mine, sp = 0u;
  for (;;) {
    sum = 0u; cnt = 0u; mine = 0u;
#pragma unroll
    for (unsigned j = 0; j < 16; ++j) { const unsigned c = xb_ld(&bar[XB_XCNT(j)]); sum += c; cnt += (c > 0u) ? 1u : 0u; mine = (j == x) ? c : mine; }
    if (sum == G) break;
    __builtin_amdgcn_s_sleep(1);
    if ((++sp & 255u) == 0u) { if (xb_ld(&bar[XB_TMO])) break; if (sp > XB_SPIN_CAP) { atomicAdd(&bar[XB_TMO], 1u); break; } }
  }
  nloc = mine > 0u ? mine : 1u; nx = cnt > 0u ? cnt : 1u;
}
DI void xcd_barrier(const XcdBarrier& b) {
  asm volatile("s_waitcnt vmcnt(0)" ::: "memory");
  __syncthreads();
  if (threadIdx.x == 0) {
    unsigned* bar = b.bar;
    __builtin_amdgcn_s_waitcnt(0);
    unsigned nloc = b.st[0], nx = b.st[1];
    if (nloc == 0u) { xcd_barrier_complete(bar, b.x, nloc, nx); b.st[0] = nloc; b.st[1] = nx; }
    const unsigned old = xb_add(&bar[XB_XSUB(b.x)], 1u);
    const unsigned gen = old / nloc;
    if (old + 1u == (gen + 1u) * nloc) {
      __builtin_amdgcn_fence(__ATOMIC_RELEASE, "agent");
      asm volatile("s_waitcnt vmcnt(0)" ::: "memory");
      const unsigned og = xb_add(&bar[XB_TOP], 1u);
      const unsigned tg = og / nx;
      if (og + 1u == (tg + 1u) * nx) xb_add(&bar[XB_TOPGEN], 1u);
      else XB_SPIN(xb_ld(&bar[XB_TOPGEN]) == tg, bar);
      __builtin_amdgcn_fence(__ATOMIC_ACQUIRE, "agent");
      xb_add(&bar[XB_XGEN(b.x)], 1u);
      asm volatile("s_waitcnt vmcnt(0)" ::: "memory");
    } else {
      XB_SPIN(xb_ld(&bar[XB_XGEN(b.x)]) == gen, bar);
      __builtin_amdgcn_fence(__ATOMIC_ACQUIRE, "agent");
      asm volatile("s_waitcnt vmcnt(0)" ::: "memory");
    }
  }
  __syncthreads();
}

__global__ void __launch_bounds__(NTHR) fwd_kernel(Params p) {
  extern __shared__ __attribute__((aligned(16))) char smem[];
  int pidx = 0;
#define RUN_PHASE() (pidx >= p.ph0 && pidx < p.ph1)
#define END_PHASE() do { if (pidx >= p.ph0 && pidx + 1 < p.ph1) { if (pidx == 0) cg::this_grid().sync(); else xcd_barrier(xb); } ++pidx; } while (0)
  volatile LAS unsigned* xst = (volatile LAS unsigned*)(smem + SMEM_BYTES - 32);
  if (threadIdx.x == 0) { xst[0] = 0u; xst[1] = 0u; }
  __syncthreads();
  XcdBarrier xb = xcd_barrier_post((unsigned*)(p.ws + OFF_BAR), xst);
#define PHASE_ENV() char* ws = p.ws; bf16_t* hb = (bf16_t*)(ws + OFF_HB); bf16_t* memhb = (bf16_t*)(ws + OFF_MEMHB); f32x2* rope = (f32x2*)(ws + OFF_ROPE); \
  bf16_t* qkv = (bf16_t*)(ws + OFF_R); bf16_t* qc = (bf16_t*)(ws + OFF_R); bf16_t* act = (bf16_t*)(ws + OFF_R); char* wl = ws + (size_t)l * SZ_WLAYER; \
  bf16_t* xb = (bf16_t*)(ws + OFF_XB); float* ssp = (float*)(ws + OFF_SSP); \
  (void)hb; (void)memhb; (void)rope; (void)qkv; (void)qc; (void)act; (void)wl; (void)xb; (void)ssp;

  if (RUN_PHASE()) {
    int rot = 0;
#pragma unroll 1
    for (int l = 0; l < 2; ++l) {
      PHASE_ENV();
      convert_w(p.w_in + (size_t)l * 1024 * 2304, p.g_mix + l * 1024, (bf16_t*)(wl + OFF_WIN), 1024, 2304, 0, smem, rot);
      convert_w(p.w_out + (size_t)l * 1024 * 1024, nullptr, (bf16_t*)(wl + OFF_WOUT), 1024, 1024, 0, smem, rot);
      convert_w(p.wc_q + (size_t)l * 1024 * 512, p.g_cross + l * 1024, (bf16_t*)(wl + OFF_WCQ), 1024, 512, 0, smem, rot);
      convert_w(p.wc_kv + (size_t)l * 1024 * 1024, p.g_mem + l * 1024, (bf16_t*)(wl + OFF_WCKV), 1024, 1024, 0, smem, rot);
      convert_w(p.wc_o + (size_t)l * 512 * 1024, nullptr, (bf16_t*)(wl + OFF_WCO), 512, 1024, 0, smem, rot);
      convert_w(p.w_gu + (size_t)l * 1024 * 5632, p.g_ffn + l * 1024, (bf16_t*)(wl + OFF_WGU), 1024, 5632, 1, smem, rot);
      convert_w(p.w_dn + (size_t)l * 2816 * 1024, nullptr, (bf16_t*)(wl + OFF_WDN), 2816, 1024, 0, smem, rot);
    }
    if (blockIdx.x == 0 && threadIdx.x < 64) {
#pragma unroll 1
      for (int l = 0; l < 2; ++l) {
        PHASE_ENV();
        const int lane = opaque_tid() & 63;
        const float lam_init = l == 0 ? 0.2f : 0.35550906759096926f;
        const float sA = 8.f * gain_bound(p.ga_q + l * 64, 64) * gain_bound(p.ga_k + l * 64, 64) * LOG2E;
        const float sB = 8.f * gain_bound(p.gb_q + l * 64, 64) * gain_bound(p.gb_k + l * 64, 64) * LOG2E;
        const float sC = 11.313708498984761f * gain_bound(p.gc_q + l * 128, 128) * gain_bound(p.gc_k + l * 128, 128) * LOG2E;
        const float d1 = wave_sum(p.lq1[l * 64 + lane] * p.lk1[l * 64 + lane]), d2 = wave_sum(p.lq2[l * 64 + lane] * p.lk2[l * 64 + lane]);
        const float lam = expf(d1) - expf(d2) + lam_init;
        float* sc = (float*)(ws + OFF_SCAL) + l * 8;
        if (lane == 0) { sc[0] = sA; sc[1] = sB; sc[2] = sC; sc[3] = lam; sc[4] = 1.f - lam_init; ((unsigned*)(ws + OFF_SCAL + 128))[l] = 0u; }
      }
    }
    { const int l = 0; PHASE_ENV(); rope_table(rope); norm_rows(p.memp, p.mems, 512, 1536, memhb, nullptr); norm_rows(p.xp, p.xs, TP, T, xb, ssp); }
  }
  END_PHASE();

#pragma unroll 1
  for (int l = 0; l < 2; ++l) {
    if (RUN_PHASE()) {
      PHASE_ENV();
      EpiQKV e{qkv, p.ga_q + l * 64, p.ga_k + l * 64, p.gb_q + l * 64, p.gb_k + l * 64, rope, ssp};
      gemm_phase(xb, LDH, (const bf16_t*)(wl + OFF_WIN), 1024 + KPAD, T, 2304, 1024, smem, e);
      if (l == 0) {
#pragma unroll 1
        for (int l2 = 0; l2 < 2; ++l2) {
          EpiN128 ek{(bf16_t*)(ws + OFF_MEMK + l2 * SZ_MEMK), (size_t)1536 * 128, 128, p.gc_k + l2 * 128, 1.f, 512, (bf16_t*)(ws + OFF_MEMVT + l2 * SZ_MEMK), 1536, nullptr};
          gemm_phase(memhb, LDH, (const bf16_t*)(ws + (size_t)l2 * SZ_WLAYER + OFF_WCKV), 1024 + KPAD, 1536, 1024, 1024, smem, ek);
        }
      }
    }
    END_PHASE();
    if (RUN_PHASE()) {
      PHASE_ENV();
      const float* scal = (const float*)(ws + OFF_SCAL) + l * 8;
      unsigned* qctr = (unsigned*)(ws + OFF_SCAL + 128) + l;
      volatile int* qslot = (volatile int*)(smem + SMEM_BYTES - 16);
#pragma unroll 1
      for (;;) {
        __syncthreads();
        if (threadIdx.x == 0) *qslot = (int)atomicAdd(qctr, 1u);
        __syncthreads();
        const int it = __builtin_amdgcn_readfirstlane(*qslot);
        if (it >= 1536) break;
        int isB, seq_tok0, S, hk, qb;
        if (it < 256) { isB = 0; S = 8192; const int combo = it >> 6; seq_tok0 = (combo >> 1) * 8192; hk = combo & 1; qb = it & 63; }
        else if (it < 512) { const int j = it - 256; isB = 1; S = 8192; const int combo = j >> 6; seq_tok0 = (combo >> 1) * 8192; hk = 3 - (combo & 1); qb = j & 63; }
        else if (it < 768) { const int j = it - 512; isB = 0; S = 4096; const int combo = j >> 5; seq_tok0 = TP + (combo >> 1) * 4096; hk = combo & 1; qb = j & 31; }
        else if (it < 896) { const int j = it - 768; isB = 1; S = 8192; seq_tok0 = (j >> 6) * 8192; hk = 1; qb = j & 63; }
        else if (it < 1152) { const int j = it - 896; isB = 1; S = 4096; const int combo = j >> 5; seq_tok0 = TP + (combo >> 1) * 4096; hk = 3 - (combo & 1); qb = j & 31; }
        else if (it < 1280) { const int j = it - 1152; isB = 1; S = 4096; seq_tok0 = TP + (j >> 5) * 4096; hk = 1; qb = j & 31; }
        else if (it < 1408) { const int j = it - 1280; isB = 1; S = 8192; seq_tok0 = (j >> 6) * 8192; hk = 0; qb = j & 63; }
        else { const int j = it - 1408; isB = 1; S = 4096; seq_tok0 = TP + (j >> 5) * 4096; hk = 0; qb = j & 31; }
        if (isB) attn_b_item(qkv, hb, seq_tok0, S, hk, qb, scal, p.gb_sub + l * 128, smem);
        else attn_a_item(qkv, hb, seq_tok0, S, hk, qb, 0.f, smem);
      }
    }
    END_PHASE();
    if (RUN_PHASE()) {
      PHASE_ENV();
      EpiResid e{xb, ssp, nullptr};
      gemm_phase(hb, LDH, (const bf16_t*)(wl + OFF_WOUT), 1024 + KPAD, T, 1024, 1024, smem, e);
    }
    END_PHASE();
    if (RUN_PHASE()) {
      PHASE_ENV();
      EpiN128 e{qc, 128, 512, p.gc_q + l * 128, 0.08838834764831845f * LOG2E, 512, nullptr, 0, ssp};
      gemm_phase(xb, LDH, (const bf16_t*)(wl + OFF_WCQ), 1024 + KPAD, T, 512, 1024, smem, e);
    }
    END_PHASE();
    if (RUN_PHASE()) {
      PHASE_ENV();
#pragma unroll 1
      for (int it = blockIdx.x; it < 512; it += gridDim.x)
        attn_c_item(qc, (const bf16_t*)(ws + OFF_MEMK + l * SZ_MEMK), (const bf16_t*)(ws + OFF_MEMVT + l * SZ_MEMK), hb, it & 3, it >> 2, 0.f, smem);
    }
    END_PHASE();
    if (RUN_PHASE()) {
      PHASE_ENV();
      EpiResid e{xb, ssp, nullptr};
      gemm_phase(hb, LDCO, (const bf16_t*)(wl + OFF_WCO), 512 + KPAD, T, 1024, 512, smem, e);
    }
    END_PHASE();
    if (RUN_PHASE()) {
      PHASE_ENV();
      EpiSwiGLU e{act, ssp};
      gemm_phase(xb, LDH, (const bf16_t*)(wl + OFF_WGU), 1024 + KPAD, T, 5632, 1024, smem, e);
    }
    END_PHASE();
    if (RUN_PHASE()) {
      PHASE_ENV();
      EpiResid e{xb, ssp, l == 1 ? p.out : nullptr};
      gemm_phase(act, LDACT, (const bf16_t*)(wl + OFF_WDN), 2816 + KPAD, T, 1024, 2816, smem, e);
    }
    if (l == 0) END_PHASE();
  }
}


#ifndef DBG_STOP
#define DBG_STOP 0
#endif
#if DBG_STOP
__global__ void dump_kernel(const bf16_t* src, size_t n_src, float* out) {
  const size_t n = (size_t)T * 1024;
  for (size_t i = (size_t)blockIdx.x * blockDim.x + threadIdx.x; i < n; i += (size_t)gridDim.x * blockDim.x) {
    float acc = 0.f;
    for (size_t j = i; j < n_src; j += n) acc += __uint_as_float((unsigned)src[j] << 16);
    out[i] = acc;
  }
}
#endif
constexpr int N_PHASES = 17;
#ifndef MK_MULTI_LAUNCH
#define MK_MULTI_LAUNCH 0
#endif
extern "C" void kernel_launch(void* const* d_in, const int* in_sizes, int n_in, void* d_out, int out_size, void* d_ws, size_t ws_size, hipStream_t stream) {
  static int grid_blocks = 0;
  if (!grid_blocks) {
    int dev = 0, cus = 0, per_cu = 0;
    (void)hipGetDevice(&dev);
    (void)hipDeviceGetAttribute(&cus, hipDeviceAttributeMultiprocessorCount, dev);
    (void)hipFuncSetAttribute((const void*)fwd_kernel, hipFuncAttributeMaxDynamicSharedMemorySize, SMEM_BYTES);
    (void)hipOccupancyMaxActiveBlocksPerMultiprocessor(&per_cu, fwd_kernel, NTHR, SMEM_BYTES);
    if (per_cu > 1) per_cu = 1;
    grid_blocks = cus * per_cu;
    if (ws_size < WS_NEED) fprintf(stderr, "workspace too small: %zu < %zu\n", ws_size, WS_NEED);
  }
  Params p{};
  const float** f = (const float**)&p;
  for (int i = 0; i < 26; ++i) f[i] = (const float*)d_in[i];
  p.out = (float*)d_out; p.ws = (char*)d_ws;
#if MK_MULTI_LAUNCH
#if DBG_STOP
  for (int ph = 0; ph < DBG_STOP; ++ph) {
    p.ph0 = ph; p.ph1 = ph + 1;
    hipLaunchKernelGGL(fwd_kernel, dim3(grid_blocks), dim3(NTHR), SMEM_BYTES, stream, p);
  }
  hipLaunchKernelGGL(dump_kernel, dim3(2048), dim3(256), 0, stream, (const bf16_t*)((char*)d_ws + DBG_OFF), (size_t)DBG_N, (float*)d_out);
#else
  for (int ph = 0; ph < N_PHASES; ++ph) {
    p.ph0 = ph; p.ph1 = ph + 1;
    hipLaunchKernelGGL(fwd_kernel, dim3(grid_blocks), dim3(NTHR), SMEM_BYTES, stream, p);
  }
#endif
#else
  p.ph0 = 0; p.ph1 = N_PHASES;
  (void)hipMemsetAsync((char*)d_ws + OFF_BAR, 0, XCD_BAR_WORDS * 4, stream);
  void* args[] = {&p};
  hipError_t e = hipLaunchCooperativeKernel((void*)fwd_kernel, dim3(grid_blocks), dim3(NTHR), args, SMEM_BYTES, stream);
  if (e != hipSuccess) fprintf(stderr, "cooperative launch failed: %s (grid %d)\n", hipGetErrorString(e), grid_blocks);
#endif
}
```

```cpp
#include <hip/hip_runtime.h>
#include <hip/hip_cooperative_groups.h>
#include <cstdio>
#include <cstdint>
namespace cg = cooperative_groups;

#define DI __device__ __forceinline__
typedef unsigned short bf16_t;
typedef short bf16x8 __attribute__((ext_vector_type(8)));
typedef float f32x16 __attribute__((ext_vector_type(16)));
typedef float f32x4 __attribute__((ext_vector_type(4)));
typedef float f32x2 __attribute__((ext_vector_type(2)));
typedef unsigned u32x4 __attribute__((ext_vector_type(4)));
typedef unsigned u32x2 __attribute__((ext_vector_type(2)));

constexpr int T = 32768, TP = 16384;
constexpr float LOG2E = 1.4426950408889634f;
constexpr float EPS = 1e-6f;
constexpr int NTHR = 512;
constexpr int SMEM_BYTES = 135168 + 1024;

constexpr int VTP = T + 64;
constexpr size_t CHS = (size_t)64 * VTP;
constexpr int KPAD = 64, LDH = 1024 + KPAD, LDCO = 512 + KPAD, LDACT = 2816 + KPAD;
constexpr size_t SZ_WIN = 2304ull * (1024 + KPAD) * 2, SZ_WOUT = 1024ull * (1024 + KPAD) * 2, SZ_WCQ = 512ull * (1024 + KPAD) * 2, SZ_WCKV = 1024ull * (1024 + KPAD) * 2,
                 SZ_WCO = 1024ull * (512 + KPAD) * 2, SZ_WGU = 5632ull * (1024 + KPAD) * 2, SZ_WDN = 1024ull * (2816 + KPAD) * 2;
constexpr size_t OFF_WIN = 0, OFF_WOUT = OFF_WIN + SZ_WIN, OFF_WCQ = OFF_WOUT + SZ_WOUT, OFF_WCKV = OFF_WCQ + SZ_WCQ, OFF_WCO = OFF_WCKV + SZ_WCKV,
                 OFF_WGU = OFF_WCO + SZ_WCO, OFF_WDN = OFF_WGU + SZ_WGU, SZ_WLAYER = OFF_WDN + SZ_WDN;
constexpr size_t OFF_HB = 2 * SZ_WLAYER;
constexpr size_t OFF_MEMHB = OFF_HB + (size_t)T * LDH * 2;
constexpr size_t SZ_MEMK = 4ull * 1536 * 128 * 2;
constexpr size_t OFF_MEMK = OFF_MEMHB + 1536ull * LDH * 2;
constexpr size_t OFF_MEMVT = OFF_MEMK + 2 * SZ_MEMK;
constexpr size_t OFF_ROPE = OFF_MEMVT + 2 * SZ_MEMK;
constexpr size_t OFF_SCAL = OFF_ROPE + 128 * 16 * 8;
constexpr size_t OFF_BAR = OFF_SCAL + 256;
constexpr size_t OFF_R = OFF_BAR + 16384;
constexpr size_t OFF_XB = OFF_R + (size_t)T * LDACT * 2;
constexpr size_t OFF_SSP = OFF_XB + (size_t)T * LDH * 2;
constexpr size_t WS_NEED = OFF_SSP + (size_t)T * 16 * 4;

struct Params {
  const float* xp; const float* xs; const float* memp; const float* mems;
  const float* g_mix; const float* w_in; const float* ga_q; const float* ga_k; const float* gb_q; const float* gb_k;
  const float* lq1; const float* lk1; const float* lq2; const float* lk2; const float* gb_sub;
  const float* w_out; const float* g_cross; const float* g_mem; const float* wc_q; const float* wc_kv; const float* gc_q; const float* gc_k;
  const float* wc_o; const float* g_ffn; const float* w_gu; const float* w_dn;
  float* out; char* ws;
  int ph0; int ph1;
};

struct Params;
DI const Params* kargs() { unsigned long long kp = (unsigned long long)__builtin_amdgcn_kernarg_segment_ptr(); asm volatile("" : "+s"(kp)); return (const Params*)kp; }
DI int opaque_tid() {
  const int w = __builtin_amdgcn_readfirstlane((int)threadIdx.x >> 6);
  int t = (w << 6) | (int)__builtin_amdgcn_mbcnt_hi(~0u, __builtin_amdgcn_mbcnt_lo(~0u, 0u));
  asm volatile("" : "+v"(t)); return t; }
typedef __bf16 bf16x2_t __attribute__((ext_vector_type(2)));
DI unsigned cvt_pk(float lo, float hi) { f32x2 f = {lo, hi}; return __builtin_bit_cast(unsigned, __builtin_convertvector(f, bf16x2_t)); }
DI int crow(int i, int h) { return (i & 3) + 8 * (i >> 2) + 4 * h; }
template <int CTRL> DI float dppf(float v) { return __builtin_bit_cast(float, __builtin_amdgcn_update_dpp(0, __builtin_bit_cast(int, v), CTRL, 0xF, 0xF, true)); }
DI float rdlane(float v, int l) { return __builtin_bit_cast(float, __builtin_amdgcn_readlane(__builtin_bit_cast(int, v), l)); }
DI float wave_sum(float v) {
  v += dppf<0xB1>(v); v += dppf<0x4E>(v); v += dppf<0x141>(v); v += dppf<0x140>(v);
  return (rdlane(v, 0) + rdlane(v, 16)) + (rdlane(v, 32) + rdlane(v, 48));
}
DI float wave_max(float v) {
  v = fmaxf(v, dppf<0xB1>(v)); v = fmaxf(v, dppf<0x4E>(v)); v = fmaxf(v, dppf<0x141>(v)); v = fmaxf(v, dppf<0x140>(v));
  return fmaxf(fmaxf(rdlane(v, 0), rdlane(v, 16)), fmaxf(rdlane(v, 32), rdlane(v, 48)));
}
DI float half_sum(float x) {
  int idx = (int)((__builtin_amdgcn_mbcnt_hi(~0u, __builtin_amdgcn_mbcnt_lo(~0u, 0u)) ^ 32u) << 2);
  asm volatile("" : "+v"(idx));
  return x + __builtin_bit_cast(float, __builtin_amdgcn_ds_bpermute(idx, __builtin_bit_cast(int, x)));
}
DI int seqpos(int t) { return t < TP ? (t & 8191) : (t & 4095); }
DI f32x16 zero16() { f32x16 z; for (int i = 0; i < 16; ++i) z[i] = 0.f; return z; }
#define MFMA32(a, b, c) __builtin_amdgcn_mfma_f32_32x32x16_bf16((a), (b), (c), 0, 0, 0)

constexpr int GSTG = 32768;
constexpr int GEMM_XCH = 4 * GSTG;

DI void glds16(const void* g, char* l) { __builtin_amdgcn_global_load_lds((const unsigned*)g, (__attribute__((address_space(3))) unsigned*)l, 16, 0, 0); }
#define WAIT_VM0() asm volatile("s_waitcnt vmcnt(0)" ::: "memory")
#define WAIT_VMN(n) asm volatile("s_waitcnt vmcnt(" #n ") lgkmcnt(0)" ::: "memory")

template <class Epi>
DI void gemm_phase(const bf16_t* __restrict__ A, int lda, const bf16_t* __restrict__ Bt, int ldb, int M, int N, int K, char* smem, const Epi& epi) {
  const int tid = opaque_tid(), lane = tid & 63, w = tid >> 6;
  const int wm = w & 1, wn = w >> 1, r = lane & 31, h = lane >> 5;
  const int nN = N >> 8, nM = M >> 8, nk = K >> 5;
  const bool xcd = ((nM & 7) == 0) && ((gridDim.x & 7) == 0);
  const int first = xcd ? (int)(blockIdx.x >> 3) : (int)blockIdx.x, stride = xcd ? (int)(gridDim.x >> 3) : (int)gridDim.x, tot = xcd ? (nM >> 3) * nN : nM * nN;
  const int ntl = first < tot ? (tot - first + stride - 1) / stride : 0;
  if (ntl == 0) return;
#define TILE_MN(i, m0, n0) do { const int j_ = first + (i) * stride; const int q_ = j_ / nN; (n0) = (j_ - q_ * nN) << 8; (m0) = (xcd ? (int)(blockIdx.x & 7) + 8 * q_ : q_) << 8; } while (0)
  unsigned ga[2], gb[2];
#pragma unroll
  for (int i = 0; i < 2; ++i) {
    const int row = (w + 8 * i) * 16 + (lane >> 2), j = (lane & 3) ^ ((row >> 2) & 3);
    ga[i] = (unsigned)(row * lda + j * 8);
    gb[i] = (unsigned)(row * ldb + j * 8);
  }
  char* ldsw = smem + w * 1024 + lane * 16;
  const int sw = (r >> 2) & 3;
  const int a_off = (wm * 128 + r) * 64 + ((h ^ (sw & 1)) << 4);
  const int b_off = 16384 + (wn * 64 + r) * 64 + ((h ^ (sw & 1)) << 4);
  const int swz = (sw & 2) << 4;
  const int nk2 = nk >> 1, G = ntl * nk2;
  int it_i = 0, it_k = 0;
  const bf16_t* iA; const bf16_t* iB;
  { int m0, n0; TILE_MN(0, m0, n0); iA = A + (size_t)m0 * lda; iB = Bt + (size_t)n0 * ldb; }
#define ISSUE_PART(step, part) do { char* d_ = ldsw + ((step) & 1) * 2 * GSTG + ((part) >> 1) * GSTG + ((part) & 1) * 16384; \
    const bf16_t* s_ = (((part) & 1) ? iB : iA) + it_k * 64 + ((part) >> 1) * 32; const unsigned* o_ = ((part) & 1) ? gb : ga; \
    glds16(s_ + o_[0], d_); glds16(s_ + o_[1], d_ + 8192); } while (0)
#define ISSUE_ADV() do { if (++it_k == nk2) { it_k = 0; ++it_i; if (it_i < ntl) { int m0_, n0_; TILE_MN(it_i, m0_, n0_); iA = A + (size_t)m0_ * lda; iB = Bt + (size_t)n0_ * ldb; } } } while (0)
#define ISSUE(step) do { ISSUE_PART(step, 0); ISSUE_PART(step, 1); ISSUE_PART(step, 2); ISSUE_PART(step, 3); ISSUE_ADV(); } while (0)
#define LOADF(bf, af, rr) do { const char* s_ = sp + ((rr) >> 1) * GSTG + ((((rr) & 1) * 32) ^ swz); \
    _Pragma("unroll") for (int tn = 0; tn < 2; ++tn) bf[tn] = *(const bf16x8*)(s_ + b_off + tn * 2048); \
    _Pragma("unroll") for (int tm = 0; tm < 4; ++tm) af[tm] = *(const bf16x8*)(s_ + a_off + tm * 2048); } while (0)
#define MMAS(bf, af) do { \
    _Pragma("unroll") for (int tn = 0; tn < 2; ++tn) _Pragma("unroll") for (int tm = 0; tm < 4; ++tm) acc[tn][tm] = MFMA32(bf[tn], af[tm], acc[tn][tm]); \
    } while (0)
  __syncthreads();
  ISSUE(0);
  f32x16 acc[2][4];
#pragma unroll
  for (int a = 0; a < 2; ++a)
#pragma unroll
    for (int b = 0; b < 4; ++b) acc[a][b] = zero16();
  int ct_i = 0, ct_k = 0;
  if (__builtin_amdgcn_readfirstlane(w) >= 4) __builtin_amdgcn_s_setprio(1);
  const bool early = w < 4;
#pragma unroll 1
  for (int g = 0; g < G; ++g) {
    WAIT_VMN(0);
    __builtin_amdgcn_s_barrier();
    const bool more = g + 1 < G;
    const char* sp = smem + (g & 1) * 2 * GSTG;
    bf16x8 bf0[2], af0[4], bf1[2], af1[4];
    LOADF(bf0, af0, 0);
    LOADF(bf1, af1, 1);
    if (more) ISSUE_PART(g + 1, 0);
    MMAS(bf0, af0);
    LOADF(bf0, af0, 2);
    if (more) ISSUE_PART(g + 1, 1);
    MMAS(bf1, af1);
    LOADF(bf1, af1, 3);
    if (more) ISSUE_PART(g + 1, 2);
    MMAS(bf0, af0);
    if (more) { ISSUE_PART(g + 1, 3); ISSUE_ADV(); }
    MMAS(bf1, af1);
    if (++ct_k == nk2) {
      ct_k = 0;
      int m0, n0; TILE_MN(ct_i, m0, n0); ++ct_i;
      if (Epi::STAGED) __syncthreads();
      epi(acc, m0 + wm * 128, n0 + wn * 64, smem, smem + (g & 1) * 2 * GSTG + w * 8192);
#pragma unroll
      for (int a = 0; a < 2; ++a)
#pragma unroll
        for (int b = 0; b < 4; ++b) acc[a][b] = zero16();
    }
  }
  __builtin_amdgcn_s_setprio(0);
  WAIT_VMN(0);
  __syncthreads();
#undef LOADF
#undef MMAS
#undef ISSUE
#undef ISSUE_PART
#undef ISSUE_ADV
#undef TILE_MN
}

DI float row_rstd(const float* ssp, int t) {
  const f32x4* q = (const f32x4*)(ssp + (size_t)t * 16);
  const f32x4 a = q[0], b = q[1], c = q[2], d = q[3];
  const float s = ((a.x + a.y) + (a.z + a.w)) + ((b.x + b.y) + (b.z + b.w)) + ((c.x + c.y) + (c.z + c.w)) + ((d.x + d.y) + (d.z + d.w));
  return rsqrtf(s * (1.f / 1024.f) + EPS);
}
struct EpiQKV {
  static constexpr bool STAGED = false;
  bf16_t* qkv; const float* gaq; const float* gak; const float* gbq; const float* gbk; const f32x2* rope; const float* ssp;
  DI void operator()(f32x16 (&acc)[2][4], int mb, int nb, char*, char*) const {
    const int tid_ = opaque_tid(), lane = tid_ & 63, c = lane & 31, h = lane >> 5;
    const int chunk = nb >> 6;
    int kind; const float* g = gaq;
    if (chunk < 8) { kind = 0; g = gaq; } else if (chunk < 10) { kind = 1; g = gak; } else if (chunk < 12) { kind = 2; }
    else if (chunk < 20) { kind = 3; g = gbq; } else if (chunk < 28) { kind = 4; g = gbk; } else { kind = 2; }
    bf16_t* dst = qkv + (size_t)chunk * CHS;
    if (kind == 2) {
#pragma unroll
      for (int tm = 0; tm < 4; ++tm) {
        const int t = mb + tm * 32 + c;
        const float rstd = row_rstd(ssp, t);
#pragma unroll
        for (int tn = 0; tn < 2; ++tn)
#pragma unroll
          for (int i = 0; i < 16; i += 2) {
            const unsigned pk = cvt_pk(acc[tn][tm][i] * rstd, acc[tn][tm][i + 1] * rstd);
            dst[(size_t)(tn * 32 + crow(i, h)) * VTP + t] = (bf16_t)(pk & 0xffff);
            dst[(size_t)(tn * 32 + crow(i + 1, h)) * VTP + t] = (bf16_t)(pk >> 16);
          }
      }
      return;
    }
    const bool dorope = kind <= 1, isq = (kind == 0 || kind == 3);
    const int xidx = (lane ^ 32) << 2;
    const float qmul = isq ? 0.125f * LOG2E : 1.f;
#pragma unroll
    for (int tm = 0; tm < 4; ++tm) {
      __builtin_amdgcn_sched_barrier(0);
      const int t = mb + tm * 32 + c;
      const float rstd = row_rstd(ssp, t);
      float ss = 0.f;
#pragma unroll
      for (int tn = 0; tn < 2; ++tn)
#pragma unroll
        for (int i = 0; i < 16; ++i) { acc[tn][tm][i] *= rstd; ss += acc[tn][tm][i] * acc[tn][tm][i]; }
      ss = half_sum(ss);
      const float rs = rsqrtf(ss * (1.f / 64.f) + EPS);
#pragma unroll
      for (int tn = 0; tn < 2; ++tn)
#pragma unroll
        for (int g4 = 0; g4 < 4; ++g4) {
          const f32x4 gv = *(const f32x4*)(g + tn * 32 + 8 * g4 + 4 * h);
          acc[tn][tm][4 * g4] *= rs * gv.x; acc[tn][tm][4 * g4 + 1] *= rs * gv.y; acc[tn][tm][4 * g4 + 2] *= rs * gv.z; acc[tn][tm][4 * g4 + 3] *= rs * gv.w;
        }
      if (dorope) {
        const int pos = seqpos(t);
#pragma unroll
        for (int tn = 0; tn < 2; ++tn) {
          __builtin_amdgcn_sched_barrier(0);
          const int pp = tn == 0 ? (pos >> 6) : (pos & 63);
#pragma unroll
          for (int i = 0; i < 8; ++i) {
            const int j = (i & 3) + 4 * h + 8 * (i >> 2);
            const f32x2 cs = rope[pp * 16 + j];
            const float x1 = acc[tn][tm][i], x2 = acc[tn][tm][i + 8];
            acc[tn][tm][i] = x1 * cs.x - x2 * cs.y;
            acc[tn][tm][i + 8] = x2 * cs.x + x1 * cs.y;
          }
        }
      }
#pragma unroll
      for (int tn = 0; tn < 2; ++tn)
#pragma unroll
        for (int q = 0; q < 2; ++q) {
          u32x2 pa, pb;
          pa.x = cvt_pk(acc[tn][tm][8 * q] * qmul, acc[tn][tm][8 * q + 1] * qmul); pa.y = cvt_pk(acc[tn][tm][8 * q + 2] * qmul, acc[tn][tm][8 * q + 3] * qmul);
          pb.x = cvt_pk(acc[tn][tm][8 * q + 4] * qmul, acc[tn][tm][8 * q + 5] * qmul); pb.y = cvt_pk(acc[tn][tm][8 * q + 6] * qmul, acc[tn][tm][8 * q + 7] * qmul);
          const u32x2 mine = h ? pb : pa, give = h ? pa : pb;
          u32x2 got;
          got.x = (unsigned)__builtin_amdgcn_ds_bpermute(xidx, (int)give.x);
          got.y = (unsigned)__builtin_amdgcn_ds_bpermute(xidx, (int)give.y);
          u32x4 v;
          if (h) { v.x = got.x; v.y = got.y; v.z = mine.x; v.w = mine.y; } else { v.x = mine.x; v.y = mine.y; v.z = got.x; v.w = got.y; }
          *(u32x4*)(dst + (size_t)t * 64 + tn * 32 + 8 * (2 * q + h)) = v;
        }
    }
  }
};

struct EpiResid {
  static constexpr bool STAGED = true;
  bf16_t* xb; float* ssp; float* out;
  DI void operator()(f32x16 (&acc)[2][4], int mb, int nb, char*, char* stg) const {
    const int tid_ = opaque_tid(), lane = tid_ & 63, c = lane & 31, h = lane >> 5;
    const int rsub = lane >> 4, ch = lane & 15;
#pragma unroll
    for (int tm = 0; tm < 4; ++tm) {
#pragma unroll
      for (int tn = 0; tn < 2; ++tn)
#pragma unroll
        for (int g4 = 0; g4 < 4; ++g4) {
          const int k = tn * 8 + 2 * g4 + h;
          f32x4 v; v.x = acc[tn][tm][4 * g4]; v.y = acc[tn][tm][4 * g4 + 1]; v.z = acc[tn][tm][4 * g4 + 2]; v.w = acc[tn][tm][4 * g4 + 3];
          *(f32x4*)(stg + c * 256 + ((k ^ (c & 15)) << 4)) = v;
        }
#pragma unroll
      for (int kk = 0; kk < 8; ++kk) {
        const int rr = 4 * kk + rsub;
        const f32x4 v = *(const f32x4*)(stg + rr * 256 + ((ch ^ (rr & 15)) << 4));
        const int t = mb + tm * 32 + rr, n = nb + ch * 4;
        bf16_t* xp_ = xb + (size_t)t * LDH + n;
        const u32x2 xr = *(const u32x2*)xp_;
        f32x4 rv;
        rv.x = __uint_as_float(xr.x << 16) + v.x; rv.y = __uint_as_float(xr.x & 0xffff0000u) + v.y;
        rv.z = __uint_as_float(xr.y << 16) + v.z; rv.w = __uint_as_float(xr.y & 0xffff0000u) + v.w;
        u32x2 pk; pk.x = cvt_pk(rv.x, rv.y); pk.y = cvt_pk(rv.z, rv.w);
        *(u32x2*)xp_ = pk;
        if (out) *(f32x4*)(out + (size_t)t * 1024 + n) = rv;
        float ss = (rv.x * rv.x + rv.y * rv.y) + (rv.z * rv.z + rv.w * rv.w);
        ss += dppf<0xB1>(ss); ss += dppf<0x4E>(ss); ss += dppf<0x141>(ss); ss += dppf<0x140>(ss);
        if (ch == 0) ssp[(size_t)t * 16 + (nb >> 6)] = ss;
      }
    }
  }
};

struct EpiN128 {
  static constexpr bool STAGED = false;
  bf16_t* dstK; size_t kHeadStride; int kRowStride; const float* gain; float mul; int nsplit; bf16_t* dstVt; int vtld; const float* ssp;
  DI void operator()(f32x16 (&acc)[2][4], int mb, int nb, char* smem, char*) const {
    const int tid_ = opaque_tid(), lane = tid_ & 63, c = lane & 31, h = lane >> 5, w = tid_ >> 6;
    float* xch = (float*)(smem + GEMM_XCH);
    if (nb >= nsplit) {
      const int nv = nb - nsplit;
#pragma unroll
      for (int tm = 0; tm < 4; ++tm) {
        const int t = mb + tm * 32 + c;
#pragma unroll
        for (int tn = 0; tn < 2; ++tn)
#pragma unroll
          for (int i = 0; i < 16; i += 2) {
            const unsigned pk = cvt_pk(acc[tn][tm][i], acc[tn][tm][i + 1]);
            dstVt[(size_t)(nv + tn * 32 + crow(i, h)) * vtld + t] = (bf16_t)(pk & 0xffff);
            dstVt[(size_t)(nv + tn * 32 + crow(i + 1, h)) * vtld + t] = (bf16_t)(pk >> 16);
          }
      }
      return;
    }
    float ssv[4];
#pragma unroll
    for (int tm = 0; tm < 4; ++tm) {
      if (ssp) { const float rstd = row_rstd(ssp, mb + tm * 32 + c);
#pragma unroll
        for (int tn = 0; tn < 2; ++tn)
#pragma unroll
          for (int i = 0; i < 16; ++i) acc[tn][tm][i] *= rstd; }
      float ss = 0.f;
#pragma unroll
      for (int tn = 0; tn < 2; ++tn)
#pragma unroll
        for (int i = 0; i < 16; ++i) ss += acc[tn][tm][i] * acc[tn][tm][i];
      ss = half_sum(ss);
      ssv[tm] = ss;
      if (h == 0) xch[w * 128 + tm * 32 + c] = ss;
    }
    __syncthreads();
    const int head = nb >> 7, nin = nb & 127;
    bf16_t* dk = dstK + (size_t)head * kHeadStride;
#pragma unroll
    for (int tm = 0; tm < 4; ++tm) {
      const int t = mb + tm * 32 + c;
      const float ss = ssv[tm] + xch[(w ^ 2) * 128 + tm * 32 + c];
      const float rs = rsqrtf(ss * (1.f / 128.f) + EPS) * mul;
#pragma unroll
      for (int tn = 0; tn < 2; ++tn)
#pragma unroll
        for (int g4 = 0; g4 < 4; ++g4) {
          const int n = nin + tn * 32 + 8 * g4 + 4 * h;
          const f32x4 gv = *(const f32x4*)(gain + n);
          u32x2 pk;
          pk.x = cvt_pk(acc[tn][tm][4 * g4] * rs * gv.x, acc[tn][tm][4 * g4 + 1] * rs * gv.y);
          pk.y = cvt_pk(acc[tn][tm][4 * g4 + 2] * rs * gv.z, acc[tn][tm][4 * g4 + 3] * rs * gv.w);
          *(u32x2*)(dk + (size_t)t * kRowStride + n) = pk;
        }
    }
    __syncthreads();
  }
};

struct EpiSwiGLU {
  static constexpr bool STAGED = false;
  bf16_t* act; const float* ssp;
  DI void operator()(f32x16 (&acc)[2][4], int mb, int nb, char*, char*) const {
    const int tid_ = opaque_tid(), lane = tid_ & 63, c = lane & 31, h = lane >> 5;
    const int jb = (nb >> 6) * 32;
    int xidx = (lane ^ 32) << 2;
#pragma unroll
    for (int tm = 0; tm < 4; ++tm) {
      const int t = mb + tm * 32 + c;
      const float rstd = row_rstd(ssp, t);
      u32x2 pk[4];
#pragma unroll
      for (int g4 = 0; g4 < 4; ++g4) {
        float o[4];
#pragma unroll
        for (int e = 0; e < 4; ++e) {
          const float gt = acc[0][tm][4 * g4 + e] * rstd, up = acc[1][tm][4 * g4 + e] * rstd;
          o[e] = gt * __builtin_amdgcn_rcpf(1.f + __builtin_amdgcn_exp2f(-gt * LOG2E)) * up;
        }
        pk[g4].x = cvt_pk(o[0], o[1]); pk[g4].y = cvt_pk(o[2], o[3]);
      }
#pragma unroll
      for (int q = 0; q < 2; ++q) {
        const u32x2 mine = h ? pk[2 * q + 1] : pk[2 * q];
        const u32x2 give = h ? pk[2 * q] : pk[2 * q + 1];
        u32x2 got;
        got.x = (unsigned)__builtin_amdgcn_ds_bpermute(xidx, (int)give.x);
        got.y = (unsigned)__builtin_amdgcn_ds_bpermute(xidx, (int)give.y);
        u32x4 v;
        if (h) { v.x = got.x; v.y = got.y; v.z = mine.x; v.w = mine.y; } else { v.x = mine.x; v.y = mine.y; v.z = got.x; v.w = got.y; }
        *(u32x4*)(act + (size_t)t * LDACT + jb + 8 * (2 * q + h)) = v;
      }
    }
  }
};

DI void norm_rows(const float* src0, const float* src1, int split, int nrows, bf16_t* dst, float* ssp) {
  const int tid_ = opaque_tid(), lane = tid_ & 63, w = tid_ >> 6;
  for (int row = blockIdx.x * 8 + w; row < nrows; row += gridDim.x * 8) {
    const float* p = row < split ? src0 + (size_t)row * 1024 : src1 + (size_t)(row - split) * 1024;
    f32x4 v[4];
#pragma unroll
    for (int i = 0; i < 4; ++i) v[i] = *(const f32x4*)(p + i * 256 + lane * 4);
    float ss = 0.f;
#pragma unroll
    for (int i = 0; i < 4; ++i) ss += v[i].x * v[i].x + v[i].y * v[i].y + v[i].z * v[i].z + v[i].w * v[i].w;
    ss = wave_sum(ss);
    const float rs = ssp ? 1.f : rsqrtf(ss * (1.f / 1024.f) + EPS);
    if (ssp && lane < 16) ssp[(size_t)row * 16 + lane] = lane == 0 ? ss : 0.f;
#pragma unroll
    for (int i = 0; i < 4; ++i) {
      u32x2 pk; pk.x = cvt_pk(v[i].x * rs, v[i].y * rs); pk.y = cvt_pk(v[i].z * rs, v[i].w * rs);
      *(u32x2*)(dst + (size_t)row * LDH + i * 256 + lane * 4) = pk;
    }
  }
}

DI void convert_w(const float* __restrict__ W, const float* __restrict__ g, bf16_t* __restrict__ Wt, int K, int N, int mode, char* smem, int& rot) {
  float* s = (float*)smem;
  const int tid = opaque_tid();
  const int nkt = K >> 6, nnt = N >> 6, nt = nkt * nnt;
  int start = (int)blockIdx.x - rot; if (start < 0) start += gridDim.x;
  for (int tile = start; tile < nt; tile += gridDim.x) {
    const int k0 = (tile / nnt) << 6, n0 = (tile % nnt) << 6;
    {
      const int row = tid >> 3, col = (tid & 7) * 8;
      const float gg = g ? g[k0 + row] : 1.f;
      const f32x4 a = *(const f32x4*)(W + (size_t)(k0 + row) * N + n0 + col);
      const f32x4 b = *(const f32x4*)(W + (size_t)(k0 + row) * N + n0 + col + 4);
      float* d = s + row * 65 + col;
      d[0] = a.x * gg; d[1] = a.y * gg; d[2] = a.z * gg; d[3] = a.w * gg; d[4] = b.x * gg; d[5] = b.y * gg; d[6] = b.z * gg; d[7] = b.w * gg;
    }
    __syncthreads();
    {
      const int n = tid >> 3, kc = (tid & 7) * 8;
      int nn = n0 + n;
      if (mode == 1) { if (nn < 2816) nn = (nn >> 5) * 64 + (nn & 31); else { const int j = nn - 2816; nn = (j >> 5) * 64 + 32 + (j & 31); } }
      u32x4 pk;
      pk.x = cvt_pk(s[(kc + 0) * 65 + n], s[(kc + 1) * 65 + n]); pk.y = cvt_pk(s[(kc + 2) * 65 + n], s[(kc + 3) * 65 + n]);
      pk.z = cvt_pk(s[(kc + 4) * 65 + n], s[(kc + 5) * 65 + n]); pk.w = cvt_pk(s[(kc + 6) * 65 + n], s[(kc + 7) * 65 + n]);
      *(u32x4*)(Wt + (size_t)nn * (K + KPAD) + k0 + kc) = pk;
    }
    __syncthreads();
  }
  rot = (rot + nt) % (int)gridDim.x;
}

__device__ const double kInvFreq[16] = {1.0, 0.5623413251903491, 0.31622776601683794, 0.1778279410038923, 0.1, 0.05623413251903491, 0.031622776601683794,
                                        0.01778279410038923, 0.01, 0.005623413251903491, 0.0031622776601683794, 0.001778279410038923, 0.001,
                                        0.0005623413251903491, 0.00031622776601683794, 0.0001778279410038923};
DI void rope_table(f32x2* tab) {
  const int idx = blockIdx.x * NTHR + threadIdx.x;
  if (idx < 2048) {
    const int pidx = idx >> 4, j = idx & 15;
    const double th = (double)pidx * kInvFreq[j];
    const double twopi = 6.283185307179586476925;
    const double kk = rint(th / twopi);
    const double r = th - kk * twopi, r2 = r * r;
    double ts = r, tc = 1.0, sn = r, cs = 1.0;
    for (int n = 1; n <= 15; ++n) { tc *= -r2 / (double)((2 * n - 1) * (2 * n)); cs += tc; ts *= -r2 / (double)((2 * n) * (2 * n + 1)); sn += ts; }
    f32x2 o; o.x = (float)cs; o.y = (float)sn; tab[idx] = o;
  }
}

template <int D, int DV, int QT, int NK, bool ALIBI, int QL>
DI void attn_core(const bf16_t* __restrict__ qbase, int qstride, const bf16_t* __restrict__ kbase, size_t kmapstride, const bf16_t* __restrict__ vtbase, size_t vtstride,
                  int kt0, int kt1, int kmap, float shift, float slope, int qpos0, char* smem, f32x16 (&O)[QT][DV / 32], float (&linv)[QT]) {
  constexpr int KROW = D * 2, KBYTES = NK * 64 * KROW, VBYTES = DV * 128, STAGE = KBYTES + VBYTES;
  constexpr int NKI = KBYTES / 8192, NVI = VBYTES / 8192;
  const int tid = opaque_tid(), lane = tid & 63, w = tid >> 6;
  const int c = lane & 31, h = lane >> 5;
  bf16x8 qf[QT - QL > 0 ? QT - QL : 1][D / 16];
  char* qlds = smem + 2 * STAGE + w * (QL * (D / 16) * 1024) + lane * 16;
  __syncthreads();
#pragma unroll
  for (int qt = 0; qt < QT; ++qt)
#pragma unroll
    for (int ks = 0; ks < D / 16; ++ks) {
      const bf16x8 q = *(const bf16x8*)(qbase + (size_t)(qt * 32 + c) * qstride + ks * 16 + 8 * h);
      if (qt < QT - QL) qf[qt][ks] = q; else *(bf16x8*)(qlds + ((qt - (QT - QL)) * (D / 16) + ks) * 1024) = q;
    }
#pragma unroll
  for (int qt = 0; qt < QT; ++qt) {
    linv[qt] = 0.f;
#pragma unroll
    for (int d = 0; d < DV / 32; ++d) O[qt][d] = zero16();
  }
  unsigned ksrc[NKI], vsrc[NVI];
#pragma unroll
  for (int i = 0; i < NKI; ++i) {
    const int blk = w + 8 * i;
    if (D == 64) {
      const int row = blk * 8 + (lane >> 3), j = (lane & 7) ^ ((row >> 1) & 7);
      ksrc[i] = (unsigned)((row >> 6) * (int)kmapstride + (row & 63) * 64 + j * 8);
    } else {
      const int row = blk * 4 + (lane >> 4), j = (lane & 15) ^ (row & 15);
      ksrc[i] = (unsigned)(row * 128 + j * 8);
    }
  }
#pragma unroll
  for (int i = 0; i < NVI; ++i) {
    const int row = (w + 8 * i) * 8 + (lane >> 3), j = (lane & 7) ^ ((row >> 1) & 7);
    vsrc[i] = (unsigned)(row * (int)vtstride + j * 8);
  }
  char* ldsw = smem + w * 1024 + lane * 16;
  WAIT_VM0();
  __syncthreads();
#pragma unroll
  for (int i = 0; i < NKI; ++i) glds16(kbase + (size_t)kt0 * 64 * D + ksrc[i], ldsw + (kt0 & 1) * STAGE + i * 8192);
#pragma unroll
  for (int i = 0; i < NVI; ++i) glds16(vtbase + kt0 * 64 + vsrc[i], ldsw + (kt0 & 1) * STAGE + KBYTES + i * 8192);
  WAIT_VM0();
  __syncthreads();
  const int pr = (c & 0x13) | ((c & 4) << 1) | ((c & 8) >> 1);
  int koff, kswz;
  if (D == 64) { const int sw = (pr >> 1) & 7; koff = (kmap * 64 + pr) * KROW + ((h ^ (sw & 1)) << 4); kswz = (sw & 6) << 4; }
  else { const int sw = pr & 15; koff = pr * KROW + ((h ^ (sw & 1)) << 4); kswz = (sw & 14) << 4; }
  const int vsw = (c >> 1) & 7;
  const int voff = KBYTES + c * 128 + ((h ^ (vsw & 1)) << 4), vswz = (vsw & 6) << 4;
  const float nshift = -shift;
  const float lanebase = (float)(8 * h - qpos0 - c);
  if (__builtin_amdgcn_readfirstlane(w) >= 4) __builtin_amdgcn_s_setprio(1);
#pragma unroll 1
  for (int kt = kt0; kt < kt1; ++kt) {
    const char* sb = smem + (kt & 1) * STAGE;
#pragma unroll
    for (int kk = 0; kk < 2; ++kk) {
      bf16x8 pf[QT][2];
      {
        f32x16 S[QT];
#pragma unroll
        for (int qt = 0; qt < QT; ++qt) {
          if (ALIBI) {
            const float dbase = lanebase + (float)(kt * 64 + kk * 32 - qt * 32);
            const int kb_ = kt * 64 + kk * 32, qb_ = qpos0 + qt * 32;
            if (kb_ >= qb_ + 31 || kb_ + 31 <= qb_) {
              const float sl = kb_ >= qb_ + 31 ? -slope : slope;
              const float b0 = __builtin_fmaf(sl, dbase, nshift);
#pragma unroll
              for (int i = 0; i < 16; ++i) S[qt][i] = __builtin_fmaf(sl, (float)(16 * (i >> 3) + (i & 7)), b0);
            } else {
#pragma unroll
              for (int i = 0; i < 16; ++i) S[qt][i] = __builtin_fmaf(-slope, __builtin_fabsf(dbase + (float)(16 * (i >> 3) + (i & 7))), nshift);
            }
          } else {
            S[qt] = zero16();
          }
        }
#pragma unroll
        for (int ks = 0; ks < D / 16; ++ks) {
          const bf16x8 kf = *(const bf16x8*)(sb + koff + kk * 32 * KROW + ((ks * 32) ^ kswz));
#pragma unroll
          for (int qt = 0; qt < QT; ++qt) {
            if (qt < QT - QL) S[qt] = MFMA32(kf, qf[qt][ks], S[qt]);
            else S[qt] = MFMA32(kf, *(const bf16x8*)(qlds + ((qt - (QT - QL)) * (D / 16) + ks) * 1024), S[qt]);
          }
        }
#pragma unroll
        for (int qt = 0; qt < QT; ++qt)
#pragma unroll
          for (int s = 0; s < 2; ++s) {
            float e[8];
#pragma unroll
            for (int j = 0; j < 8; ++j) { e[j] = __builtin_amdgcn_exp2f(S[qt][8 * s + j]); linv[qt] += e[j]; }
            u32x4 pk; pk.x = cvt_pk(e[0], e[1]); pk.y = cvt_pk(e[2], e[3]); pk.z = cvt_pk(e[4], e[5]); pk.w = cvt_pk(e[6], e[7]);
            pf[qt][s] = __builtin_bit_cast(bf16x8, pk);
          }
      }
#pragma unroll
      for (int d = 0; d < DV / 32; ++d)
#pragma unroll
        for (int s = 0; s < 2; ++s) {
          const bf16x8 vf = *(const bf16x8*)(sb + voff + d * 4096 + (((kk * 4 + s * 2) * 16) ^ vswz));
#pragma unroll
          for (int qt = 0; qt < QT; ++qt) O[qt][d] = MFMA32(vf, pf[qt][s], O[qt][d]);
        }
      if (kk == 0) {
      if (kt + 1 < kt1) {
        char* d = ldsw + ((kt + 1) & 1) * STAGE;
        const bf16_t* kb2 = kbase + (size_t)(kt + 1) * 64 * D; const bf16_t* vb2 = vtbase + (kt + 1) * 64;
#pragma unroll
        for (int i = 0; i < NKI; ++i) glds16(kb2 + ksrc[i], d + i * 8192);
#pragma unroll
        for (int i = 0; i < NVI; ++i) glds16(vb2 + vsrc[i], d + KBYTES + i * 8192);
      }
      }
    }
    WAIT_VM0();
    __syncthreads();
  }
  __builtin_amdgcn_s_setprio(0);
#pragma unroll
  for (int qt = 0; qt < QT; ++qt) { float l = linv[qt]; l = half_sum(l); linv[qt] = 1.f / l; }
}

DI float gain_bound(const float* g, int n) {
  const int lane = opaque_tid() & 63;
  float m = fabsf(g[lane]);
  if (n > 64) m = fmaxf(m, fabsf(g[64 + lane]));
  return wave_max(m);
}

DI void attn_a_item(const bf16_t* qkv, bf16_t* outp, int seq_tok0, int S, int kvh, int qb, float shift, char* smem) {
  const int tid_ = opaque_tid(), w = tid_ >> 6, lane = tid_ & 63, c = lane & 31, h = lane >> 5;
  const int hd = kvh * 4 + (w & 3), qrow0 = seq_tok0 + qb * 128 + (w >> 2) * 64;
  f32x16 O[2][2]; float linv[2];
  attn_core<64, 64, 2, 1, false, 0>(qkv + (size_t)hd * CHS + (size_t)qrow0 * 64, 64, qkv + (size_t)(8 + kvh) * CHS + (size_t)seq_tok0 * 64, 0,
                                 qkv + (size_t)(10 + kvh) * CHS + seq_tok0, VTP, 0, S >> 6, 0, shift, 0.f, 0, smem, O, linv);
  const int tid2 = opaque_tid(), w2 = tid2 >> 6, c2 = tid2 & 31, h2 = (tid2 >> 5) & 1;
  const int hd2 = kvh * 4 + (w2 & 3), qrow2 = seq_tok0 + qb * 128 + (w2 >> 2) * 64;
#pragma unroll
  for (int qt = 0; qt < 2; ++qt) {
    const int t = qrow2 + qt * 32 + c2;
#pragma unroll
    for (int d = 0; d < 2; ++d)
#pragma unroll
      for (int g4 = 0; g4 < 4; ++g4) {
        u32x2 pk;
        pk.x = cvt_pk(O[qt][d][4 * g4] * linv[qt], O[qt][d][4 * g4 + 1] * linv[qt]);
        pk.y = cvt_pk(O[qt][d][4 * g4 + 2] * linv[qt], O[qt][d][4 * g4 + 3] * linv[qt]);
        *(u32x2*)(outp + (size_t)t * LDH + hd2 * 64 + d * 32 + 8 * g4 + 4 * h2) = pk;
      }
  }
}

DI void attn_b_item(const bf16_t* qkv, bf16_t* outp, int seq_tok0, int S, int head, int qb, const float* scal, const float* gsub, char* smem) {
  const int tid_ = opaque_tid(), w = tid_ >> 6;
  const int map = w & 1, qp = w >> 1, qpos0 = qb * 128 + qp * 32, qrow0 = seq_tok0 + qpos0;
  const float slope = exp2f(-2.f * (float)(head + 1)) * LOG2E;
  const float shift = scal[1];
  const float wf = fminf((150.f + 2.f * shift) / slope + 1.f, 65536.f);
  const int W = __builtin_amdgcn_readfirstlane((int)wf);
  int kt0 = (qb * 128 - W) >> 6; if (kt0 < 0) kt0 = 0;
  int kt1 = ((qb * 128 + 127 + W) >> 6) + 1; if (kt1 > (S >> 6)) kt1 = S >> 6;
  f32x16 O[1][4]; float linv[1];
  attn_core<64, 128, 1, 2, true, 0>(qkv + (size_t)(12 + head * 2 + map) * CHS + (size_t)qrow0 * 64, 64, qkv + (size_t)(20 + head * 2) * CHS + (size_t)seq_tok0 * 64, CHS,
                                    qkv + (size_t)(28 + head * 2) * CHS + seq_tok0, VTP, kt0, kt1, map, shift, slope, qpos0, smem, O, linv);
  const int tid2 = opaque_tid(), lane2 = tid2 & 63, c2 = tid2 & 31, h2 = (tid2 >> 5) & 1, map2 = (tid2 >> 6) & 1, qp2 = tid2 >> 7;
  const int t = seq_tok0 + qb * 128 + qp2 * 32 + c2;
  float* xch = (float*)smem + (size_t)qp2 * 4096;
  if (map2 == 1) {
#pragma unroll
    for (int d = 0; d < 4; ++d)
#pragma unroll
      for (int i = 0; i < 16; ++i) xch[(d * 16 + i) * 64 + lane2] = O[0][d][i] * linv[0];
  }
  __syncthreads();
  if (map2 == 0) {
    const float lamv = scal[3], omul = scal[4];
    float ss = 0.f;
#pragma unroll
    for (int d = 0; d < 4; ++d)
#pragma unroll
      for (int i = 0; i < 16; ++i) {
        const float o = O[0][d][i] * linv[0] - lamv * xch[(d * 16 + i) * 64 + lane2];
        O[0][d][i] = o; ss += o * o;
      }
    ss = half_sum(ss);
    const float rs = rsqrtf(ss * (1.f / 128.f) + EPS) * omul;
#pragma unroll
    for (int d = 0; d < 4; ++d)
#pragma unroll
      for (int g4 = 0; g4 < 4; ++g4) {
        const int dv = d * 32 + 8 * g4 + 4 * h2;
        const f32x4 gv = *(const f32x4*)(gsub + dv);
        u32x2 pk;
        pk.x = cvt_pk(O[0][d][4 * g4] * rs * gv.x, O[0][d][4 * g4 + 1] * rs * gv.y);
        pk.y = cvt_pk(O[0][d][4 * g4 + 2] * rs * gv.z, O[0][d][4 * g4 + 3] * rs * gv.w);
        *(u32x2*)(outp + (size_t)t * LDH + 512 + head * 128 + dv) = pk;
      }
  }
  __syncthreads();
}

DI void attn_c_item(const bf16_t* qc, const bf16_t* memK, const bf16_t* memVt, bf16_t* co, int head, int gqb, float shift, char* smem) {
  const int tid_ = opaque_tid(), w = tid_ >> 6, lane = tid_ & 63, c = lane & 31, h = lane >> 5;
  const int tok0 = gqb * 256, qrow0 = tok0 + w * 32;
  const int ms = tok0 < TP ? (tok0 >> 13) : 2 + ((tok0 - TP) >> 12);
  f32x16 O[1][4]; float linv[1];
  attn_core<128, 128, 1, 1, false, 0>(qc + (size_t)qrow0 * 512 + head * 128, 512, memK + ((size_t)head * 1536 + ms * 256) * 128, 0,
                                   memVt + (size_t)head * 128 * 1536 + ms * 256, 1536, 0, 4, 0, shift, 0.f, 0, smem, O, linv);
  const int tid2 = opaque_tid(), c2 = tid2 & 31, h2 = (tid2 >> 5) & 1;
  const int t = tok0 + (tid2 >> 6) * 32 + c2;
#pragma unroll
  for (int d = 0; d < 4; ++d)
#pragma unroll
    for (int g4 = 0; g4 < 4; ++g4) {
      u32x2 pk;
      pk.x = cvt_pk(O[0][d][4 * g4] * linv[0], O[0][d][4 * g4 + 1] * linv[0]);
      pk.y = cvt_pk(O[0][d][4 * g4 + 2] * linv[0], O[0][d][4 * g4 + 3] * linv[0]);
      *(u32x2*)(co + (size_t)t * LDCO + head * 128 + d * 32 + 8 * g4 + 4 * h2) = pk;
    }
}


#define XB_TMO      128
#define XB_XCNT(j)  (256  + 64 * (j))
#define XB_XSUB(j)  (1280 + 64 * (j))
#define XB_XGEN(j)  (2304 + 64 * (j))
#define XB_TOP      3328
#define XB_TOPGEN   3392
#define XCD_BAR_WORDS 3456
#define XB_SPIN_CAP (1u << 20)
#define LAS __attribute__((address_space(3)))
DI unsigned xb_ld(unsigned* p)              { return __hip_atomic_load(p, __ATOMIC_RELAXED, __HIP_MEMORY_SCOPE_AGENT); }
DI unsigned xb_add(unsigned* p, unsigned v) { return __hip_atomic_fetch_add(p, v, __ATOMIC_RELAXED, __HIP_MEMORY_SCOPE_AGENT); }
DI unsigned xb_xcc_id() { return (unsigned)__builtin_amdgcn_s_getreg((3 << 11) | 20) & 0xFu; }
#define XB_SPIN(cond, bar) do { unsigned _sp = 0; while (cond) { __builtin_amdgcn_s_sleep(1); \
    if ((++_sp & 255u) == 0u) { if (xb_ld(&(bar)[XB_TMO])) break; if (_sp > XB_SPIN_CAP) { atomicAdd(&(bar)[XB_TMO], 1u); break; } } } } while (0)
struct XcdBarrier { unsigned* bar; unsigned x; volatile LAS unsigned* st; };
DI XcdBarrier xcd_barrier_post(unsigned* bar, volatile LAS unsigned* st) {
  XcdBarrier b; b.bar = bar; b.x = xb_xcc_id(); b.st = st;
  if (threadIdx.x == 0) (void)xb_add(&bar[XB_XCNT(b.x)], 1u);
  return b;
}
DI void xcd_barrier_complete(unsigned* bar, unsigned x, unsigned& nloc, unsigned& nx) {
  const unsigned G = gridDim.x;
  unsigned sum, cnt, mine, sp = 0u;
  for (;;) {
    sum = 0u; cnt = 0u; mine = 0u;
#pragma unroll
    for (unsigned j = 0; j < 16; ++j) { const unsigned c = xb_ld(&bar[XB_XCNT(j)]); sum += c; cnt += (c > 0u) ? 1u : 0u; mine = (j == x) ? c : mine; }
    if (sum == G) break;
    __builtin_amdgcn_s_sleep(1);
    if ((++sp & 255u) == 0u) { if (xb_ld(&bar[XB_TMO])) break; if (sp > XB_SPIN_CAP) { atomicAdd(&bar[XB_TMO], 1u); break; } }
  }
  nloc = mine > 0u ? mine : 1u; nx = cnt > 0u ? cnt : 1u;
}
DI void xcd_barrier(const XcdBarrier& b) {
  asm volatile("s_waitcnt vmcnt(0)" ::: "memory");
  __syncthreads();
  if (threadIdx.x == 0) {
    unsigned* bar = b.bar;
    __builtin_amdgcn_s_waitcnt(0);
    unsigned nloc = b.st[0], nx = b.st[1];
    if (nloc == 0u) { xcd_barrier_complete(bar, b.x, nloc, nx); b.st[0] = nloc; b.st[1] = nx; }
    const unsigned old = xb_add(&bar[XB_XSUB(b.x)], 1u);
    const unsigned gen = old / nloc;
    if (old + 1u == (gen + 1u) * nloc) {
      __builtin_amdgcn_fence(__ATOMIC_RELEASE, "agent");
      asm volatile("s_waitcnt vmcnt(0)" ::: "memory");
      const unsigned og = xb_add(&bar[XB_TOP], 1u);
      const unsigned tg = og / nx;
      if (og + 1u == (tg + 1u) * nx) xb_add(&bar[XB_TOPGEN], 1u);
      else XB_SPIN(xb_ld(&bar[XB_TOPGEN]) == tg, bar);
      __builtin_amdgcn_fence(__ATOMIC_ACQUIRE, "agent");
      xb_add(&bar[XB_XGEN(b.x)], 1u);
      asm volatile("s_waitcnt vmcnt(0)" ::: "memory");
    } else {
      XB_SPIN(xb_ld(&bar[XB_XGEN(b.x)]) == gen, bar);
      __builtin_amdgcn_fence(__ATOMIC_ACQUIRE, "agent");
      asm volatile("s_waitcnt vmcnt(0)" ::: "memory");
    }
  }
  __syncthreads();
}

__global__ void __launch_bounds__(NTHR) fwd_kernel(Params p) {
  extern __shared__ __attribute__((aligned(16))) char smem[];
  int pidx = 0;
#define RUN_PHASE() (pidx >= p.ph0 && pidx < p.ph1)
#define END_PHASE() do { if (pidx >= p.ph0 && pidx + 1 < p.ph1) { if (pidx == 0) cg::this_grid().sync(); else xcd_barrier(xb); } ++pidx; } while (0)
  volatile LAS unsigned* xst = (volatile LAS unsigned*)(smem + SMEM_BYTES - 32);
  if (threadIdx.x == 0) { xst[0] = 0u; xst[1] = 0u; }
  __syncthreads();
  XcdBarrier xb = xcd_barrier_post((unsigned*)(p.ws + OFF_BAR), xst);
#define PHASE_ENV() char* ws = p.ws; bf16_t* hb = (bf16_t*)(ws + OFF_HB); bf16_t* memhb = (bf16_t*)(ws + OFF_MEMHB); f32x2* rope = (f32x2*)(ws + OFF_ROPE); \
  bf16_t* qkv = (bf16_t*)(ws + OFF_R); bf16_t* qc = (bf16_t*)(ws + OFF_R); bf16_t* act = (bf16_t*)(ws + OFF_R); char* wl = ws + (size_t)l * SZ_WLAYER; \
  bf16_t* xb = (bf16_t*)(ws + OFF_XB); float* ssp = (float*)(ws + OFF_SSP); \
  (void)hb; (void)memhb; (void)rope; (void)qkv; (void)qc; (void)act; (void)wl; (void)xb; (void)ssp;

  if (RUN_PHASE()) {
    int rot = 0;
#pragma unroll 1
    for (int l = 0; l < 2; ++l) {
      PHASE_ENV();
      convert_w(p.w_in + (size_t)l * 1024 * 2304, p.g_mix + l * 1024, (bf16_t*)(wl + OFF_WIN), 1024, 2304, 0, smem, rot);
      convert_w(p.w_out + (size_t)l * 1024 * 1024, nullptr, (bf16_t*)(wl + OFF_WOUT), 1024, 1024, 0, smem, rot);
      convert_w(p.wc_q + (size_t)l * 1024 * 512, p.g_cross + l * 1024, (bf16_t*)(wl + OFF_WCQ), 1024, 512, 0, smem, rot);
      convert_w(p.wc_kv + (size_t)l * 1024 * 1024, p.g_mem + l * 1024, (bf16_t*)(wl + OFF_WCKV), 1024, 1024, 0, smem, rot);
      convert_w(p.wc_o + (size_t)l * 512 * 1024, nullptr, (bf16_t*)(wl + OFF_WCO), 512, 1024, 0, smem, rot);
      convert_w(p.w_gu + (size_t)l * 1024 * 5632, p.g_ffn + l * 1024, (bf16_t*)(wl + OFF_WGU), 1024, 5632, 1, smem, rot);
      convert_w(p.w_dn + (size_t)l * 2816 * 1024, nullptr, (bf16_t*)(wl + OFF_WDN), 2816, 1024, 0, smem, rot);
    }
    if (blockIdx.x == 0 && threadIdx.x < 64) {
#pragma unroll 1
      for (int l = 0; l < 2; ++l) {
        PHASE_ENV();
        const int lane = opaque_tid() & 63;
        const float lam_init = l == 0 ? 0.2f : 0.35550906759096926f;
        const float sA = 8.f * gain_bound(p.ga_q + l * 64, 64) * gain_bound(p.ga_k + l * 64, 64) * LOG2E;
        const float sB = 8.f * gain_bound(p.gb_q + l * 64, 64) * gain_bound(p.gb_k + l * 64, 64) * LOG2E;
        const float sC = 11.313708498984761f * gain_bound(p.gc_q + l * 128, 128) * gain_bound(p.gc_k + l * 128, 128) * LOG2E;
        const float d1 = wave_sum(p.lq1[l * 64 + lane] * p.lk1[l * 64 + lane]), d2 = wave_sum(p.lq2[l * 64 + lane] * p.lk2[l * 64 + lane]);
        const float lam = expf(d1) - expf(d2) + lam_init;
        float* sc = (float*)(ws + OFF_SCAL) + l * 8;
        if (lane == 0) { sc[0] = sA; sc[1] = sB; sc[2] = sC; sc[3] = lam; sc[4] = 1.f - lam_init; ((unsigned*)(ws + OFF_SCAL + 128))[l] = 0u; }
      }
    }
    { const int l = 0; PHASE_ENV(); rope_table(rope); norm_rows(p.memp, p.mems, 512, 1536, memhb, nullptr); norm_rows(p.xp, p.xs, TP, T, xb, ssp); }
  }
  END_PHASE();

#pragma unroll 1
  for (int l = 0; l < 2; ++l) {
    if (RUN_PHASE()) {
      PHASE_ENV();
      EpiQKV e{qkv, p.ga_q + l * 64, p.ga_k + l * 64, p.gb_q + l * 64, p.gb_k + l * 64, rope, ssp};
      gemm_phase(xb, LDH, (const bf16_t*)(wl + OFF_WIN), 1024 + KPAD, T, 2304, 1024, smem, e);
      if (l == 0) {
#pragma unroll 1
        for (int l2 = 0; l2 < 2; ++l2) {
          EpiN128 ek{(bf16_t*)(ws + OFF_MEMK + l2 * SZ_MEMK), (size_t)1536 * 128, 128, p.gc_k + l2 * 128, 1.f, 512, (bf16_t*)(ws + OFF_MEMVT + l2 * SZ_MEMK), 1536, nullptr};
          gemm_phase(memhb, LDH, (const bf16_t*)(ws + (size_t)l2 * SZ_WLAYER + OFF_WCKV), 1024 + KPAD, 1536, 1024, 1024, smem, ek);
        }
      }
    }
    END_PHASE();
    if (RUN_PHASE()) {
      PHASE_ENV();
      const float* scal = (const float*)(ws + OFF_SCAL) + l * 8;
      unsigned* qctr = (unsigned*)(ws + OFF_SCAL + 128) + l;
      volatile int* qslot = (volatile int*)(smem + SMEM_BYTES - 16);
#pragma unroll 1
      for (;;) {
        __syncthreads();
        if (threadIdx.x == 0) *qslot = (int)atomicAdd(qctr, 1u);
        __syncthreads();
        const int it = __builtin_amdgcn_readfirstlane(*qslot);
        if (it >= 1536) break;
        int isB, seq_tok0, S, hk, qb;
        if (it < 256) { isB = 0; S = 8192; const int combo = it >> 6; seq_tok0 = (combo >> 1) * 8192; hk = combo & 1; qb = it & 63; }
        else if (it < 512) { const int j = it - 256; isB = 1; S = 8192; const int combo = j >> 6; seq_tok0 = (combo >> 1) * 8192; hk = 3 - (combo & 1); qb = j & 63; }
        else if (it < 768) { const int j = it - 512; isB = 0; S = 4096; const int combo = j >> 5; seq_tok0 = TP + (combo >> 1) * 4096; hk = combo & 1; qb = j & 31; }
        else if (it < 896) { const int j = it - 768; isB = 1; S = 8192; seq_tok0 = (j >> 6) * 8192; hk = 1; qb = j & 63; }
        else if (it < 1152) { const int j = it - 896; isB = 1; S = 4096; const int combo = j >> 5; seq_tok0 = TP + (combo >> 1) * 4096; hk = 3 - (combo & 1); qb = j & 31; }
        else if (it < 1280) { const int j = it - 1152; isB = 1; S = 4096; seq_tok0 = TP + (j >> 5) * 4096; hk = 1; qb = j & 31; }
        else if (it < 1408) { const int j = it - 1280; isB = 1; S = 8192; seq_tok0 = (j >> 6) * 8192; hk = 0; qb = j & 63; }
        else { const int j = it - 1408; isB = 1; S = 4096; seq_tok0 = TP + (j >> 5) * 4096; hk = 0; qb = j & 31; }
        if (isB) attn_b_item(qkv, hb, seq_tok0, S, hk, qb, scal, p.gb_sub + l * 128, smem);
        else attn_a_item(qkv, hb, seq_tok0, S, hk, qb, 0.f, smem);
      }
    }
    END_PHASE();
    if (RUN_PHASE()) {
      PHASE_ENV();
      EpiResid e{xb, ssp, nullptr};
      gemm_phase(hb, LDH, (const bf16_t*)(wl + OFF_WOUT), 1024 + KPAD, T, 1024, 1024, smem, e);
    }
    END_PHASE();
    if (RUN_PHASE()) {
      PHASE_ENV();
      EpiN128 e{qc, 128, 512, p.gc_q + l * 128, 0.08838834764831845f * LOG2E, 512, nullptr, 0, ssp};
      gemm_phase(xb, LDH, (const bf16_t*)(wl + OFF_WCQ), 1024 + KPAD, T, 512, 1024, smem, e);
    }
    END_PHASE();
    if (RUN_PHASE()) {
      PHASE_ENV();
#pragma unroll 1
      for (int it = blockIdx.x; it < 512; it += gridDim.x)
        attn_c_item(qc, (const bf16_t*)(ws + OFF_MEMK + l * SZ_MEMK), (const bf16_t*)(ws + OFF_MEMVT + l * SZ_MEMK), hb, it & 3, it >> 2, 0.f, smem);
    }
    END_PHASE();
    if (RUN_PHASE()) {
      PHASE_ENV();
      EpiResid e{xb, ssp, nullptr};
      gemm_phase(hb, LDCO, (const bf16_t*)(wl + OFF_WCO), 512 + KPAD, T, 1024, 512, smem, e);
    }
    END_PHASE();
    if (RUN_PHASE()) {
      PHASE_ENV();
      EpiSwiGLU e{act, ssp};
      gemm_phase(xb, LDH, (const bf16_t*)(wl + OFF_WGU), 1024 + KPAD, T, 5632, 1024, smem, e);
    }
    END_PHASE();
    if (RUN_PHASE()) {
      PHASE_ENV();
      EpiResid e{xb, ssp, l == 1 ? p.out : nullptr};
      gemm_phase(act, LDACT, (const bf16_t*)(wl + OFF_WDN), 2816 + KPAD, T, 1024, 2816, smem, e);
    }
    if (l == 0) END_PHASE();
  }
}


#ifndef DBG_STOP
#define DBG_STOP 0
#endif
#if DBG_STOP
__global__ void dump_kernel(const bf16_t* src, size_t n_src, float* out) {
  const size_t n = (size_t)T * 1024;
  for (size_t i = (size_t)blockIdx.x * blockDim.x + threadIdx.x; i < n; i += (size_t)gridDim.x * blockDim.x) {
    float acc = 0.f;
    for (size_t j = i; j < n_src; j += n) acc += __uint_as_float((unsigned)src[j] << 16);
    out[i] = acc;
  }
}
#endif
constexpr int N_PHASES = 17;
#ifndef MK_MULTI_LAUNCH
#define MK_MULTI_LAUNCH 0
#endif
extern "C" void kernel_launch(void* const* d_in, const int* in_sizes, int n_in, void* d_out, int out_size, void* d_ws, size_t ws_size, hipStream_t stream) {
  static int grid_blocks = 0;
  if (!grid_blocks) {
    int dev = 0, cus = 0, per_cu = 0;
    (void)hipGetDevice(&dev);
    (void)hipDeviceGetAttribute(&cus, hipDeviceAttributeMultiprocessorCount, dev);
    (void)hipFuncSetAttribute((const void*)fwd_kernel, hipFuncAttributeMaxDynamicSharedMemorySize, SMEM_BYTES);
    (void)hipOccupancyMaxActiveBlocksPerMultiprocessor(&per_cu, fwd_kernel, NTHR, SMEM_BYTES);
    if (per_cu > 1) per_cu = 1;
    grid_blocks = cus * per_cu;
    if (ws_size < WS_NEED) fprintf(stderr, "workspace too small: %zu < %zu\n", ws_size, WS_NEED);
  }
  Params p{};
  const float** f = (const float**)&p;
  for (int i = 0; i < 26; ++i) f[i] = (const float*)d_in[i];
  p.out = (float*)d_out; p.ws = (char*)d_ws;
#if MK_MULTI_LAUNCH
#if DBG_STOP
  for (int ph = 0; ph < DBG_STOP; ++ph) {
    p.ph0 = ph; p.ph1 = ph + 1;
    hipLaunchKernelGGL(fwd_kernel, dim3(grid_blocks), dim3(NTHR), SMEM_BYTES, stream, p);
  }
  hipLaunchKernelGGL(dump_kernel, dim3(2048), dim3(256), 0, stream, (const bf16_t*)((char*)d_ws + DBG_OFF), (size_t)DBG_N, (float*)d_out);
#else
  for (int ph = 0; ph < N_PHASES; ++ph) {
    p.ph0 = ph; p.ph1 = ph + 1;
    hipLaunchKernelGGL(fwd_kernel, dim3(grid_blocks), dim3(NTHR), SMEM_BYTES, stream, p);
  }
#endif
#else
  p.ph0 = 0; p.ph1 = N_PHASES;
  (void)hipMemsetAsync((char*)d_ws + OFF_BAR, 0, XCD_BAR_WORDS * 4, stream);
  void* args[] = {&p};
  hipError_t e = hipLaunchCooperativeKernel((void*)fwd_kernel, dim3(grid_blocks), dim3(NTHR), args, SMEM_BYTES, stream);
  if (e != hipSuccess) fprintf(stderr, "cooperative launch failed: %s (grid %d)\n", hipGetErrorString(e), grid_blocks);
#endif
}
```
